# Optimizing an MI355X kernel written in HIP

```python
import jax, jax.numpy as jnp
from jax import lax
import numpy as np

D_MODEL = 1024
BATCH = 8
SEQ = 4096
DEPTH = 2

CHUNK = 64
Q_BLOCK = 128
MIX_WIDTH = D_MODEL
FOX_HEADS = 8
FOX_HEAD_DIM = 64
FOX_WIDTH = FOX_HEADS * FOX_HEAD_DIM
RET_HEADS = 4
RET_HEAD_DIM = 128
RET_WIDTH = RET_HEADS * RET_HEAD_DIM
IN_WIDTH = 3 * FOX_WIDTH + FOX_HEADS + 4 * RET_WIDTH
ROPE_BASE = 10000.0
N_GROUPS = 4
EXPERTS_PER_GROUP = 8
N_EXPERTS = N_GROUPS * EXPERTS_PER_GROUP
TOP_K_INNER = 2
D_EXPERT = D_MODEL // 2
DISPATCH_BLOCK = 128
RMS_EPS = 1e-6

kernel_name = 'hybrid_fox_retnet_hmoe_trunk'


def rmsnorm(x, w):
    xf = x.astype(jnp.float32)
    y = xf * lax.rsqrt(jnp.mean(xf * xf, axis=-1, keepdims=True) + RMS_EPS)
    return y.astype(x.dtype) * w


def head_rmsnorm(x):
    xf = x.astype(jnp.float32)
    y = xf * lax.rsqrt(jnp.mean(xf * xf, axis=-1, keepdims=True) + RMS_EPS)
    return y.astype(x.dtype)


def rotary(x):
    S, D = x.shape[1], x.shape[-1]
    half = D // 2
    inv_freq = 1.0 / (ROPE_BASE ** (jnp.arange(half, dtype=jnp.float32) / half))
    ang = jnp.arange(S, dtype=jnp.float32)[:, None] * inv_freq[None, :]
    cos = jnp.cos(ang)[None, :, None, :].astype(x.dtype)
    sin = jnp.sin(ang)[None, :, None, :].astype(x.dtype)
    x1, x2 = x[..., :half], x[..., half:]
    return jnp.concatenate([x1 * cos - x2 * sin, x1 * sin + x2 * cos], axis=-1)


def forgetting_attention(q, k, v, log_f):
    B, S, H, Dh = q.shape
    c = jnp.cumsum(log_f, axis=1).transpose(0, 2, 1)
    scale = Dh ** -0.5
    outs = []
    for i in range(S // Q_BLOCK):
        q0 = i * Q_BLOCK
        kend = q0 + Q_BLOCK
        s = jnp.einsum('bqhd,bkhd->bhqk', q[:, q0:kend], k[:, :kend]).astype(jnp.float32) * scale
        s = s + (c[:, :, q0:kend, None] - c[:, :, None, :kend])
        q_pos = q0 + jnp.arange(Q_BLOCK)
        mask = q_pos[:, None] >= jnp.arange(kend)[None, :]
        s = jnp.where(mask[None, None], s, -jnp.inf)
        p = jax.nn.softmax(s, axis=-1).astype(v.dtype)
        outs.append(jnp.einsum('bhqk,bkhd->bqhd', p, v[:, :kend]))
    return jnp.concatenate(outs, axis=1)


def retention(q, k, v):
    B, S, H, Dk = q.shape
    Dv = v.shape[-1]
    NC = S // CHUNK
    out_dtype = v.dtype
    qc = q.astype(jnp.float32).reshape(B, NC, CHUNK, H, Dk)
    kc = k.astype(jnp.float32).reshape(B, NC, CHUNK, H, Dk) * (Dk ** -0.5)
    vc = v.astype(jnp.float32).reshape(B, NC, CHUNK, H, Dv)
    log_gamma = jnp.log(1.0 - 2.0 ** (-5.0 - jnp.arange(H, dtype=jnp.float32)))
    idx = jnp.arange(CHUNK, dtype=jnp.float32)
    dist = jnp.abs(idx[:, None] - idx[None, :])
    intra_decay = jnp.exp(log_gamma[:, None, None] * dist)
    scores = jnp.einsum('bnjhd,bnlhd->bnhjl', qc, kc) * intra_decay
    intra = jnp.einsum('bnhjl,bnlhe->bnjhe', scores, vc)
    k_decay = jnp.exp(log_gamma[None, :] * (CHUNK - idx)[:, None])
    chunk_kv = jnp.einsum('bnlhd,bnlhe->nbhde', kc * k_decay[:, :, None], vc)
    chunk_decay = jnp.exp(log_gamma * CHUNK)[:, None, None]

    def step(state, kv):
        return chunk_decay * state + kv, state

    _, states = lax.scan(step, jnp.zeros((B, H, Dk, Dv), jnp.float32), chunk_kv)
    q_decay = jnp.exp(log_gamma[None, :] * idx[:, None])
    cross = jnp.einsum('bnjhd,nbhde->bnjhe', qc * q_decay[:, :, None], states)
    return (intra + cross).reshape(B, S, H, Dv).astype(out_dtype)


def mixer(h, w_in, fox_forget_b, w_out):
    B, S, _ = h.shape
    proj = h @ w_in
    splits = [int(i) for i in np.cumsum([FOX_WIDTH] * 3 + [FOX_HEADS] + [RET_WIDTH] * 3)]
    fq, fk, fv, ff, rq, rk, rv, rg = jnp.split(proj, splits, axis=-1)
    log_f = jax.nn.log_sigmoid((ff + fox_forget_b).astype(jnp.float32))
    fox = forgetting_attention(fq.reshape(B, S, FOX_HEADS, FOX_HEAD_DIM),
                               fk.reshape(B, S, FOX_HEADS, FOX_HEAD_DIM),
                               fv.reshape(B, S, FOX_HEADS, FOX_HEAD_DIM), log_f)
    ret = retention(rotary(rq.reshape(B, S, RET_HEADS, RET_HEAD_DIM)),
                    rotary(rk.reshape(B, S, RET_HEADS, RET_HEAD_DIM)),
                    rv.reshape(B, S, RET_HEADS, RET_HEAD_DIM))
    ret = head_rmsnorm(ret) * jax.nn.silu(rg).reshape(B, S, RET_HEADS, RET_HEAD_DIM)
    mixed = jnp.concatenate([fox.reshape(B, S, FOX_WIDTH), ret.reshape(B, S, RET_WIDTH)], axis=-1)
    return mixed @ w_out


def hierarchical_moe(h, w_router_group, b_router_group, w_router_expert, b_router_expert,
                     w_expert_gate, w_expert_up, w_expert_down):
    B, S, D = h.shape
    N = B * S
    K = TOP_K_INNER
    hf = h.reshape(N, D)
    g_logits = (hf @ w_router_group + b_router_group).astype(jnp.float32)
    g_prob = jax.nn.softmax(g_logits, axis=-1)
    g_idx = jnp.argmax(g_logits, axis=-1)
    g_w = jnp.take_along_axis(g_prob, g_idx[:, None], axis=-1)
    e_logits = (hf @ w_router_expert + b_router_expert).astype(jnp.float32)
    e_logits = e_logits.reshape(N, N_GROUPS, EXPERTS_PER_GROUP)
    e_in_group = jnp.take_along_axis(e_logits, g_idx[:, None, None], axis=1)[:, 0]
    top_v, top_i = lax.top_k(e_in_group, K)
    weights = (g_w * jax.nn.softmax(top_v, axis=-1)).reshape(-1)
    eid = (g_idx[:, None] * EXPERTS_PER_GROUP + top_i).reshape(-1).astype(jnp.int32)
    tok = jnp.repeat(jnp.arange(N, dtype=jnp.int32), K)
    order = jnp.argsort(eid)
    eid_s, tok_s, w_s = eid[order], tok[order], weights[order]
    counts = jnp.bincount(eid, length=N_EXPERTS)
    starts = jnp.cumsum(counts) - counts
    padded = (counts + DISPATCH_BLOCK - 1) // DISPATCH_BLOCK * DISPATCH_BLOCK
    pend = jnp.cumsum(padded)
    pstarts = pend - padded
    dest = pstarts[eid_s] + (jnp.arange(N * K, dtype=jnp.int32) - starts[eid_s])
    P = N * K + N_EXPERTS * DISPATCH_BLOCK
    tok_buf = jnp.zeros((P,), jnp.int32).at[dest].set(tok_s)
    w_buf = jnp.zeros((P,), jnp.float32).at[dest].set(w_s)
    nb = P // DISPATCH_BLOCK
    blk_e = jnp.searchsorted(pend, jnp.arange(nb, dtype=pend.dtype) * DISPATCH_BLOCK, side='right')
    blk_e = jnp.minimum(blk_e, N_EXPERTS - 1)
    xb = hf[tok_buf].reshape(nb, DISPATCH_BLOCK, D)

    def expert_block(args):
        xblk, e = args
        a = jax.nn.silu(xblk @ w_expert_gate[e]) * (xblk @ w_expert_up[e])
        return a @ w_expert_down[e]

    yb = lax.map(expert_block, (xb, blk_e)).reshape(P, D)
    out = jax.ops.segment_sum(yb * w_buf.astype(yb.dtype)[:, None], tok_buf, num_segments=N)
    return out.reshape(B, S, D)


def setup_inputs(seed: int = 0) -> dict:
    key = jax.random.key(seed)
    ks = jax.random.split(key, 14)
    f32 = jnp.float32

    def nrm(k, shape, scale):
        return jax.random.normal(k, shape, f32) * scale

    return {
        'x': nrm(ks[0], (BATCH, SEQ, D_MODEL), 1.0),
        'norm_mix_w': 1.0 + nrm(ks[1], (DEPTH, D_MODEL), 0.1),
        'w_in': nrm(ks[2], (DEPTH, D_MODEL, IN_WIDTH), D_MODEL ** -0.5),
        'fox_forget_b': jax.random.uniform(ks[3], (DEPTH, FOX_HEADS), f32, 1.0, 3.0),
        'w_out': nrm(ks[4], (DEPTH, MIX_WIDTH, D_MODEL), MIX_WIDTH ** -0.5),
        'norm_ffn_w': 1.0 + nrm(ks[5], (DEPTH, D_MODEL), 0.1),
        'w_router_group': nrm(ks[6], (DEPTH, D_MODEL, N_GROUPS), D_MODEL ** -0.5),
        'b_router_group': nrm(ks[7], (DEPTH, N_GROUPS), 0.01),
        'w_router_expert': nrm(ks[8], (DEPTH, D_MODEL, N_EXPERTS), D_MODEL ** -0.5),
        'b_router_expert': nrm(ks[9], (DEPTH, N_EXPERTS), 0.01),
        'w_expert_gate': nrm(ks[10], (DEPTH, N_EXPERTS, D_MODEL, D_EXPERT), D_MODEL ** -0.5),
        'w_expert_up': nrm(ks[11], (DEPTH, N_EXPERTS, D_MODEL, D_EXPERT), D_MODEL ** -0.5),
        'w_expert_down': nrm(ks[12], (DEPTH, N_EXPERTS, D_EXPERT, D_MODEL), D_EXPERT ** -0.5),
        'norm_final_w': 1.0 + nrm(ks[13], (D_MODEL,), 0.1),
    }


def reference(x, norm_mix_w, w_in, fox_forget_b, w_out, norm_ffn_w, w_router_group, b_router_group,
              w_router_expert, b_router_expert, w_expert_gate, w_expert_up, w_expert_down, norm_final_w):
    for layer in range(DEPTH):
        x = x + mixer(rmsnorm(x, norm_mix_w[layer]), w_in[layer], fox_forget_b[layer], w_out[layer])
        x = x + hierarchical_moe(rmsnorm(x, norm_ffn_w[layer]), w_router_group[layer], b_router_group[layer],
                                 w_router_expert[layer], b_router_expert[layer], w_expert_gate[layer],
                                 w_expert_up[layer], w_expert_down[layer])
    return rmsnorm(x, norm_final_w)
```

```cpp
#include <hip/hip_runtime.h>
#include <hip/hip_bf16.h>
#include <cstdio>
#include <cstdint>
#include <cmath>

#ifndef MK_DIAG
#define MK_DIAG 0
#endif
#ifndef MK_FP8
#define MK_FP8 1
#endif
#ifndef MK_MIX8
#define MK_MIX8 1
#endif
#ifndef MK_CHAIN
#define MK_CHAIN 1
#endif
#ifndef MK_CHAIN4
#define MK_CHAIN4 1
#endif
#ifndef MK_MULTI
#define MK_MULTI 0
#endif

constexpr int BATCH = 8, SEQ = 4096, DM = 1024, M = BATCH * SEQ, DEPTH = 2;
constexpr int FH = 8, FD = 64, RH = 4, RD = 128;
constexpr int INW = 3592;
constexpr int NPROJ = 3584;
constexpr int PQ = 0, PK = 512, PV = 1024, PRQ = 1536, PRK = 2048, PRV = 2560, PRG = 3072;
constexpr int SRC_FQ = 0, SRC_FK = 512, SRC_FV = 1024, SRC_FF = 1536, SRC_RQ = 1544, SRC_RK = 2056, SRC_RV = 2568, SRC_RG = 3080;
constexpr int NE = 32, NG = 4, EPG = 8, DE = 512;
constexpr float RMS_EPS = 1e-6f;
constexpr int NWAVES = 8, NTHREADS = 512;
constexpr float MIX_SCALE = MK_MIX8 ? 8.f : 1.f;
constexpr int MSZ = MK_MIX8 ? 1 : 2;
constexpr int XSZ = MK_FP8 ? 1 : 2;
constexpr int CAP = 32768;
constexpr int MAXTILES = 288;
constexpr int SLOTS = MAXTILES * 256;

constexpr size_t MiB = 1u << 20;
constexpr size_t WS_CTL = 0, CTL_ZERO_BYTES = 1 * MiB;
constexpr size_t WS_RFR = 512 * 1024;
constexpr int RFR_N = 32 * 3 * 64;
constexpr size_t WS_WFP = 768 * 1024;
constexpr size_t WS_ROT = 1 * MiB;
constexpr size_t WS_LOGF = 3 * MiB;
constexpr size_t WS_ROWSS = 4 * MiB;
constexpr size_t WS_RT = 6 * MiB;
constexpr size_t WS_TOK = 7 * MiB;
constexpr size_t WS_WL = 11 * MiB;
constexpr size_t WS_SEG = 15 * MiB;
constexpr size_t WS_WIN = 31 * MiB;
constexpr size_t WS_WOUT = 45 * MiB;
constexpr size_t WS_W1 = 49 * MiB;
constexpr size_t WS_W2 = 177 * MiB;
constexpr size_t WS_HN = 241 * MiB;
constexpr size_t WS_PROJ = 305 * MiB;
constexpr size_t WS_A1 = WS_PROJ;
constexpr size_t WS_Y = WS_PROJ + 72 * MiB;
constexpr size_t WS_CL = 529 * MiB;
constexpr size_t WS_END = 530 * MiB;
constexpr size_t WS_XB = WS_W1 + 64 * MiB;
static_assert(MK_FP8 == 1, "WS_XB overlays the bf16-only half of WS_W1");
static_assert(WS_Y + (size_t)SLOTS * 1024 * 2 <= WS_END && WS_PROJ + (size_t)M * NPROJ * 2 <= WS_END, "d_ws map");
constexpr int CW_TMO = 0, CW_CODE = 1;
constexpr int CW_CNT = 64;
constexpr int CW_RDY = 65536;
constexpr int CW_PC0 = 60;
constexpr int CW_Q = 48;
constexpr int CW_KB = 8192;
constexpr int CW_DIAG = 256;
constexpr int CW_BAR = 4096;

constexpr int RING_BYTES = 131072;
constexpr int AUX_OFF = RING_BYTES;
constexpr int AUX_BYTES = 16384 - 512;
constexpr int MISC_OFF = RING_BYTES + AUX_BYTES;
constexpr int LDS_BYTES = 147456;

#define GAS __attribute__((address_space(1)))
#define LAS __attribute__((address_space(3)))
typedef unsigned short bf16;
typedef unsigned v4u __attribute__((ext_vector_type(4)));
typedef unsigned v2u __attribute__((ext_vector_type(2)));
typedef float f32x4 __attribute__((ext_vector_type(4)));
typedef float f32x2 __attribute__((ext_vector_type(2)));
typedef float f32x16 __attribute__((ext_vector_type(16)));
typedef short bf16x8 __attribute__((ext_vector_type(8)));
typedef short s16x4 __attribute__((ext_vector_type(4)));
typedef GAS unsigned gu32;
#define RLX_AGENT __ATOMIC_RELAXED, __HIP_MEMORY_SCOPE_AGENT
#define LDS_WAIT() asm volatile("s_waitcnt lgkmcnt(0)" ::: "memory")
#define VM_WAIT() asm volatile("s_waitcnt vmcnt(0)" ::: "memory")
__device__ __forceinline__ unsigned f2bf(float f) { unsigned u = __builtin_bit_cast(unsigned, f); return (u + 0x7fffu + ((u >> 16) & 1u)) >> 16; }
typedef float f32x2h_t __attribute__((ext_vector_type(2))); typedef __bf16 bf16x2h_t __attribute__((ext_vector_type(2)));
__device__ __forceinline__ unsigned pk2(float lo, float hi) { const f32x2h_t v = {lo, hi}; return __builtin_bit_cast(unsigned, __builtin_convertvector(v, bf16x2h_t)); }
__device__ __forceinline__ float eps_s() { float e = 1e-6f; asm volatile("" : "+s"(e)); return e; }
__device__ __forceinline__ float bf2f(unsigned b) { return __builtin_bit_cast(float, b << 16); }
#ifndef MK_V0TID
#define MK_V0TID 0
#endif
#if MK_V0TID
__device__ __forceinline__ int lane_id() { return (int)(threadIdx.x & 63u); }
#else
__device__ __forceinline__ int lane_id() { int l; asm volatile("v_mbcnt_lo_u32_b32 %0, -1, 0\n\tv_mbcnt_hi_u32_b32 %0, -1, %0" : "=v"(l)); return l; }
#endif
__device__ __forceinline__ int shx_i(int v, int o) { return __builtin_amdgcn_ds_bpermute((lane_id() ^ o) << 2, v); }
__device__ __forceinline__ float shx_f(float v, int o) { return __builtin_bit_cast(float, __builtin_amdgcn_ds_bpermute((lane_id() ^ o) << 2, __builtin_bit_cast(int, v))); }
__device__ __forceinline__ float shup_f(float v, int o) { const int l = lane_id(); return __builtin_bit_cast(float, __builtin_amdgcn_ds_bpermute((l >= o ? l - o : l) << 2, __builtin_bit_cast(int, v))); }
__device__ __forceinline__ float wave_sum(float v) {
    const int l = lane_id();
#pragma unroll
    for (int o = 1; o < 64; o <<= 1) v += __builtin_bit_cast(float, __builtin_amdgcn_ds_bpermute((l ^ o) << 2, __builtin_bit_cast(int, v)));
    return v;
}
__device__ __forceinline__ float silu_f(float v) { return v * __builtin_amdgcn_rcpf(1.f + __builtin_amdgcn_exp2f(-1.4426950408889634f * v)); }
__host__ __device__ __forceinline__ float ret_lg2(int h) { return h == 0 ? -0.04580368846654892f : h == 1 ? -0.022720076143741608f : h == 2 ? -0.011315313167870045f : -0.00564656313508749f; }
namespace pg8 {
constexpr int BM = 256, BK = 64, HALF = 128, HTB = HALF * BK * 2  , STAGE_BYTES = 8 * HTB, NXCD = 8, WGM = 8;
__host__ __device__ __forceinline__ int lds_byte(int r, int c) { const int st = (r >> 4) * 2 + (c >> 5), rr = r & 15, cc = c & 31, ob = rr * 64 + cc * 2; return st * 1024 + (ob ^ (((ob >> 9) & 1) << 5)); }
__host__ __device__ __forceinline__ void stage_rc(int b, int& R, int& C) { const int st = b / 1024, sb = b % 1024, swz = sb ^ (((sb >> 9) & 1) << 5); R = (st >> 1) * 16 + swz / 64; C = (st & 1) * 32 + (swz % 64) / 2; }
__host__ __device__ __forceinline__ int perm32(int rho) { const int n = rho >> 4, i = rho & 15; return 8 * (i >> 2) + 4 * n + (i & 3); }

struct Unit { int pm, pn, e, ml; };

template <int NM, int NN, int ESZ = 2> struct DenseOrder {
    static constexpr bool GATHER = false;
    const char* A; const char* Bt; int K; int G, c;
    __device__ void init(const void* A_, const void* Bt_, int K_, int G_, int c_) { A = (const char*)A_; Bt = (const char*)Bt_; K = K_; G = G_; c = c_; }
    __device__ __forceinline__ bool next(int i, Unit& u) const {
        constexpr int nwg = NM * NN, q = nwg / NXCD, r = nwg % NXCD, nig = WGM * NN;
        if (i * G + c >= nwg) return false;
#ifndef MK_ROTUNITS
#define MK_ROTUNITS 1
#endif
#if MK_ROTUNITS
        constexpr bool rot_ok = (nwg % 256) == 0;
        const int ii = (rot_ok && G == 256) ? (i + (c & 7) * (MK_ROTUNITS)) % (nwg / 256) : i;
#else
        const int ii = i;
#endif
        const int L = ii * G + c;
        int wgid = L; { const int xcd = wgid % NXCD, off = wgid / NXCD; wgid = (xcd < r ? xcd * (q + 1) : r * (q + 1) + (xcd - r) * q) + off; }
        const int gid = wgid / nig, fm = gid * WGM, gsz = (NM - fm) < WGM ? (NM - fm) : WGM;
        static_assert(NM % WGM == 0, "row tiles come in full groups of 8 (gsz == 8)");
        u.pm = fm + ((wgid % nig) % WGM); u.pn = (wgid % nig) / WGM; u.e = 0; u.ml = 0; (void)gsz; return true;
    }
    __device__ __forceinline__ const char* a_base(const Unit& u) const { return A + (size_t)u.pm * BM * K * ESZ; }
    __device__ __forceinline__ const char* b_base(const Unit& u) const { return Bt + (size_t)u.pn * BM * K * ESZ; }
    __device__ __forceinline__ unsigned a_row_off(int, int) const { return 0u; }
    __device__ __forceinline__ void a_ready(const Unit&, int) const {}
};

typedef int v4i_t __attribute__((ext_vector_type(4)));
__device__ __forceinline__ unsigned pk4_fp8(float a, float b, float c, float d) { int r = __builtin_amdgcn_cvt_pk_fp8_f32(a, b, 0, false); r = __builtin_amdgcn_cvt_pk_fp8_f32(c, d, r, true); return (unsigned)r; }
typedef float f32x2c_t __attribute__((ext_vector_type(2))); typedef __bf16 bf16x2c_t __attribute__((ext_vector_type(2)));
__device__ __forceinline__ unsigned cvt_pk_bf16(float lo, float hi) { const f32x2c_t v = {lo, hi}; const bf16x2c_t b = __builtin_convertvector(v, bf16x2c_t); return __builtin_bit_cast(unsigned, b); }

template <class Epi, class Sched, bool ALIGN_EPI, int ESZ = 2>
__device__ __forceinline__ void gemm_phase(LAS unsigned char* lds, const int K, const Sched& S, const Epi& E, const int wave_) {
    int tid = wave_ * 64 + lane_id(); asm volatile("" : "+v"(tid));
    const int wid = __builtin_amdgcn_readfirstlane(tid >> 6), lane = tid & 63, wr = wid >> 2, wc = wid & 3, fr = lane & 15, fq = lane >> 4;
    int Kop = K; asm volatile("" : "+s"(Kop));
    const int KB = Kop * ESZ, nt = KB / (BK * 2);
    int RA[2], CA[2]; unsigned voffB[2];
#pragma unroll
    for (int i = 0; i < 2; ++i) { int R, C; stage_rc(tid * 16 + i * 8192, R, C); const int Rb = Epi::PERM ? ((R & ~31) + perm32(R & 31)) : R;
        RA[i] = R; CA[i] = C; voffB[i] = (unsigned)(Rb * KB + C * 2); }
    const size_t kstep = (size_t)(BK * 2);
    const size_t ah1 = Sched::GATHER ? 0 : (size_t)HALF * KB;
    const size_t hstep = (size_t)HALF * KB;
    const unsigned ldsw = (unsigned)wid * 1024u;
    const unsigned ldsb = (unsigned)(__UINTPTR_TYPE__)lds + ldsw;
    const int aoff = lds_byte(wr * 64 + fr, fq * 8), boff = lds_byte(wc * 32 + fr, fq * 8);
#define PG8_SA(b, h) (((b) * 2 + (h)) * HTB)
#define PG8_SB(b, h) ((4 + (b) * 2 + (h)) * HTB)
#ifndef MK_STAGE_ASM
#define MK_STAGE_ASM 1
#endif
#if MK_STAGE_ASM
#define PG8_STAGE(bufoff, gbase, voff) do { _Pragma("unroll") for (int _i = 0; _i < 2; ++_i) { unsigned keep_; \
        asm volatile("s_mov_b32 %0, m0\n\ts_mov_b32 m0, %3\n\ts_nop 0\n\tglobal_load_lds_dwordx4 %1, %2\n\ts_mov_b32 m0, %0" : "=&s"(keep_) \
                     : "v"((voff)[_i]), "s"((const void*)(gbase)), "s"(ldsb + (unsigned)((bufoff) + _i * 8192)) : "memory"); } } while (0)
#else
#define PG8_STAGE(bufoff, gbase, voff) do { _Pragma("unroll") for (int _i = 0; _i < 2; ++_i) \
        __builtin_amdgcn_global_load_lds((const unsigned*)((const char*)(gbase) + (voff)[_i]), (LAS unsigned*)(lds + (bufoff) + ldsw + _i * 8192), 16, 0, 0); } while (0)
#endif
#define PG8_LDA(dst, b, h) do { _Pragma("unroll") for (int m = 0; m < 4; ++m) _Pragma("unroll") for (int k = 0; k < 2; ++k) dst[m][k] = *(const LAS bf16x8*)(lds + PG8_SA(b, h) + aoff + m * 2048 + k * 1024); } while (0)
#define PG8_LDB(dst, b, h) do { _Pragma("unroll") for (int n = 0; n < 2; ++n) _Pragma("unroll") for (int k = 0; k < 2; ++k) dst[n][k] = *(const LAS bf16x8*)(lds + PG8_SB(b, h) + boff + n * 2048 + k * 1024); } while (0)
#define PG8_CAT(x, y) __builtin_shufflevector(__builtin_bit_cast(v4i_t, x), __builtin_bit_cast(v4i_t, y), 0, 1, 2, 3, 4, 5, 6, 7)
#define PG8_MMA(ai, bj, At, Bt) do { __builtin_amdgcn_s_setprio(1); if constexpr (ESZ == 2) { _Pragma("unroll") for (int m = 0; m < 4; ++m) _Pragma("unroll") for (int n = 0; n < 2; ++n) _Pragma("unroll") for (int k = 0; k < 2; ++k) \
        acc[ai][bj][m][n] = __builtin_amdgcn_mfma_f32_16x16x32_bf16(Bt[n][k], At[m][k], acc[ai][bj][m][n], 0, 0, 0); } else { _Pragma("unroll") for (int m = 0; m < 4; ++m) _Pragma("unroll") for (int n = 0; n < 2; ++n) \
        acc[ai][bj][m][n] = __builtin_amdgcn_mfma_scale_f32_16x16x128_f8f6f4(PG8_CAT(Bt[n][0], Bt[n][1]), PG8_CAT(At[m][0], At[m][1]), acc[ai][bj][m][n], 0, 0, 0, 0, 0, 0); } \
        __builtin_amdgcn_s_setprio(0); } while (0)
#define PG8_WAIT_V(n) asm volatile("s_waitcnt vmcnt(" #n ")" ::: "memory")
#define PG8_WAIT_L(n) asm volatile("s_waitcnt lgkmcnt(" #n ")" ::: "memory")
#define PG8_BAR __builtin_amdgcn_s_barrier()
#define PG8_SCHED __builtin_amdgcn_sched_barrier(0)
#define PG8_SETV(v, ui_, u_) do { _Pragma("unroll") for (int _h = 0; _h < 2; ++_h) _Pragma("unroll") for (int _i = 0; _i < 2; ++_i) \
        v[_h][_i] = Sched::GATHER ? (S.a_row_off(ui_, _h * HALF + RA[_i]) + (unsigned)CA[_i] * 2u) : ((unsigned)(RA[_i] * KB + CA[_i] * 2)); } while (0)
    Unit cur, nxt; int ui = 0;
    if (!S.next(0, cur)) return;
    f32x4 acc[2][2][4][2];
#pragma unroll
    for (int a = 0; a < 2; ++a)
#pragma unroll
        for (int b = 0; b < 2; ++b)
#pragma unroll
            for (int m = 0; m < 4; ++m)
#pragma unroll
                for (int n = 0; n < 2; ++n) acc[a][b][m][n] = (f32x4){0.f, 0.f, 0.f, 0.f};
    bf16x8 At[4][2], B0[2][2], B1[2][2];
    unsigned vc[2][2], vn[2][2];
    PG8_SETV(vc, 0, cur);
    const char* cA = S.a_base(cur); const char* cB = S.b_base(cur);
    S.a_ready(cur, wave_);
    PG8_STAGE(PG8_SB(0, 0), cB, voffB); PG8_STAGE(PG8_SB(0, 1), cB + hstep, voffB); PG8_STAGE(PG8_SA(0, 0), cA, vc[0]); PG8_STAGE(PG8_SA(0, 1), cA + ah1, vc[1]);
    if (wr == 1) PG8_BAR;
    PG8_WAIT_V(2); PG8_BAR;
    PG8_STAGE(PG8_SB(1, 0), cB + kstep, voffB); PG8_STAGE(PG8_SA(1, 0), cA + kstep, vc[0]); PG8_STAGE(PG8_SB(1, 1), cB + hstep + kstep, voffB);
    PG8_WAIT_V(6); PG8_BAR;
#ifndef MK_EPIOVL
#define MK_EPIOVL 0
#endif
    bool pre = false;
    for (;;) {
        const bool has_next = S.next(ui + 1, nxt);
        const char* nA = has_next ? S.a_base(nxt) : cA; const char* nB = has_next ? S.b_base(nxt) : cB;
        if (Sched::GATHER) { if (has_next) { PG8_SETV(vn, ui + 1, nxt); } else {
#pragma unroll
            for (int h = 0; h < 2; ++h)
#pragma unroll
                for (int i = 0; i < 2; ++i) vn[h][i] = vc[h][i]; } }
#pragma nounroll
        for (int t = 0; t < nt; t += 2) {
            const bool last = (t == nt - 2);
            const bool skp = MK_EPIOVL && pre && t == 0;
            const char* a1 = cA + (size_t)(t + 1) * kstep;
            const char* a2 = last ? nA : cA + (size_t)(t + 2) * kstep; const char* b2 = last ? nB : cB + (size_t)(t + 2) * kstep;
            const char* a3 = a2 + kstep; const char* b3 = b2 + kstep;
            if (last && has_next) S.a_ready(nxt, wave_);
            PG8_LDB(B0, 0, 0); PG8_LDB(B1, 0, 1); PG8_SCHED; PG8_LDA(At, 0, 0); if (!skp) PG8_STAGE(PG8_SA(1, 1), a1 + ah1, vc[1]);
            if (Sched::GATHER && last) { _Pragma("unroll") for (int h = 0; h < 2; ++h) _Pragma("unroll") for (int i = 0; i < 2; ++i) vc[h][i] = vn[h][i]; }
            if (!skp) PG8_WAIT_V(8); PG8_WAIT_L(0); PG8_BAR; PG8_MMA(0, 0, At, B0); PG8_MMA(0, 1, At, B1); PG8_BAR; PG8_SCHED;
            PG8_LDA(At, 0, 1); PG8_STAGE(PG8_SB(0, 0), b2, voffB); PG8_STAGE(PG8_SB(0, 1), b2 + hstep, voffB); PG8_STAGE(PG8_SA(0, 0), a2, vc[0]);
            if (!skp) PG8_WAIT_V(8); PG8_WAIT_L(0); PG8_BAR; PG8_MMA(1, 0, At, B0); PG8_MMA(1, 1, At, B1); PG8_BAR; PG8_SCHED;
            PG8_LDB(B0, 1, 0); PG8_LDB(B1, 1, 1); PG8_SCHED; PG8_LDA(At, 1, 0); PG8_STAGE(PG8_SA(0, 1), a2 + ah1, vc[1]);
            if (!skp) PG8_WAIT_V(8); PG8_WAIT_L(0); PG8_BAR; PG8_MMA(0, 0, At, B0); PG8_MMA(0, 1, At, B1); PG8_BAR; PG8_SCHED;
            PG8_LDA(At, 1, 1); PG8_STAGE(PG8_SB(1, 0), b3, voffB); PG8_STAGE(PG8_SB(1, 1), b3 + hstep, voffB); PG8_STAGE(PG8_SA(1, 0), a3, vc[0]);
            PG8_WAIT_V(8); PG8_WAIT_L(0); PG8_BAR; PG8_MMA(1, 0, At, B0); PG8_MMA(1, 1, At, B1); PG8_BAR; PG8_SCHED;
        }
        if (MK_EPIOVL && has_next) { PG8_STAGE(PG8_SA(1, 1), nA + kstep + ah1, vc[1]); pre = true; }
        if constexpr (ALIGN_EPI) { if (wr == 0) PG8_BAR; }
        if (MK_EPIOVL) PG8_WAIT_V(0);
        E(acc, cur, ui);
        if (!has_next) break;
#pragma unroll
        for (int a = 0; a < 2; ++a)
#pragma unroll
            for (int b = 0; b < 2; ++b)
#pragma unroll
                for (int m = 0; m < 4; ++m)
#pragma unroll
                    for (int n = 0; n < 2; ++n) acc[a][b][m][n] = (f32x4){0.f, 0.f, 0.f, 0.f};
        cur = nxt; cA = nA; cB = nB; ++ui;
        if constexpr (ALIGN_EPI) { if (wr == 1) PG8_BAR; }
    }
    PG8_WAIT_V(0);
    if constexpr (!ALIGN_EPI) { if (wr == 0) PG8_BAR; }
    PG8_BAR;
#undef PG8_SA
#undef PG8_SB
#undef PG8_STAGE
#undef PG8_LDA
#undef PG8_LDB
#undef PG8_MMA
#undef PG8_CAT
#undef PG8_WAIT_V
#undef PG8_WAIT_L
#undef PG8_BAR
#undef PG8_SCHED
#undef PG8_SETV
}
}
namespace attn_body {
using hb16=__hip_bfloat16;
using u32x4=__attribute__((ext_vector_type(4)))unsigned;
constexpr int NHEAD=FH,D=FD,QP=NPROJ,OP=DM;
constexpr int NW=8,QBLK=32,QB=QBLK*NW,KVBLK=64,NQB=SEQ/QB;
__device__ __forceinline__ int crow(int r,int hi){return (r&3)+8*(r>>2)+4*hi;}
#define SBAR() __builtin_amdgcn_sched_barrier(0)
__device__ __forceinline__ void cmask(f32x16&p0,f32x16&p1,int jb,int qrel,int hi){
  float NEG=-INFINITY; asm volatile("":"+v"(NEG)); int kb=64*jb+4*hi;
  #pragma unroll
  for(int r=0;r<16;++r){int kv=kb+(r&3)+8*(r>>2); if(kv>qrel)p0[r]=NEG; if(kv+32>qrel)p1[r]=NEG;}
}
constexpr int NSLOT=3, SLOTB=8192;
constexpr int LDS_K=0, LDS_V=NSLOT*SLOTB, LDS_WS=2*NSLOT*SLOTB, LDS_OST=LDS_WS+NW*64*4, LDS_BYTES=LDS_OST+NW*4096;
constexpr int LDS_CL=90112, LDS_CLTMP=LDS_CL+SEQ*4;
constexpr float LOG2E=1.4426950408889634f;
#ifndef MK_SKIP
#define MK_SKIP 64
#endif
constexpr int SKIP=MK_SKIP;
constexpr float C2=0.125f*LOG2E;
__device__ __forceinline__ void glds16(const void*gsrc,unsigned lds_dst){unsigned keep;
  asm volatile("s_mov_b32 %0, m0\n\ts_mov_b32 m0, %2\n\ts_nop 0\n\tglobal_load_lds_dwordx4 %1, off\n\ts_mov_b32 m0, %0":"=&s"(keep):"v"(gsrc),"s"(lds_dst):"memory");}
__device__ __forceinline__ float max3f(float a,float b,float c){float r;asm("v_max3_f32 %0, %1, %2, %3":"=v"(r):"v"(a),"v"(b),"v"(c));return r;}
__device__ __forceinline__ float max2f(float a,float b){float r;asm("v_max_f32_e32 %0, %1, %2":"=v"(r):"v"(a),"v"(b));return r;}
__device__ __forceinline__ float fadd_s(float a,float b){float r;asm("v_add_f32_e32 %0, %1, %2":"=v"(r):"v"(a),"v"(b));return r;}
__device__ __forceinline__ float fsub_s(float a,float b){float r;asm("v_sub_f32_e32 %0, %1, %2":"=v"(r):"v"(a),"v"(b));return r;}
typedef float f32x2_t __attribute__((ext_vector_type(2))); typedef __bf16 bf16x2_t __attribute__((ext_vector_type(2)));
__device__ __forceinline__ unsigned cvtpk_s(float lo,float hi){f32x2_t v={lo,hi};bf16x2_t b=__builtin_convertvector(v,bf16x2_t);return __builtin_bit_cast(unsigned,b);}
#define WAIT_BAR(N) asm volatile("s_waitcnt vmcnt(" #N ") lgkmcnt(0)\n\ts_barrier":::"memory")

typedef LAS const char* lds_cptr;
typedef short v4i16_t __attribute__((ext_vector_type(4)));
__device__ __forceinline__ void qkt(f32x16&p0,f32x16&p1,const char*Kslot,const bf16x8*qr,int r32,int hi){
  const char*kb=Kslot+hi*1024+r32*16;
  #pragma unroll
  for(int d0=0;d0<4;++d0){
    const bf16x8 b0=*reinterpret_cast<const bf16x8*>(kb+d0*2048);
    const bf16x8 b1=*reinterpret_cast<const bf16x8*>(kb+d0*2048+512);
    p0=__builtin_amdgcn_mfma_f32_32x32x16_bf16(b0,qr[d0],p0,0,0,0);p1=__builtin_amdgcn_mfma_f32_32x32x16_bf16(b1,qr[d0],p1,0,0,0);}
}
__device__ __forceinline__ void kload8(bf16x8*kf,lds_cptr kp){
  kf[0]=*(const LAS bf16x8*)(kp);      kf[1]=*(const LAS bf16x8*)(kp+512);
  kf[2]=*(const LAS bf16x8*)(kp+2048); kf[3]=*(const LAS bf16x8*)(kp+2560);
  kf[4]=*(const LAS bf16x8*)(kp+4096); kf[5]=*(const LAS bf16x8*)(kp+4608);
  kf[6]=*(const LAS bf16x8*)(kp+6144); kf[7]=*(const LAS bf16x8*)(kp+6656);
}
__device__ __forceinline__ void kload2(bf16x8*kf,lds_cptr kp,int j){ kf[2*j]=*(const LAS bf16x8*)(kp+j*2048); kf[2*j+1]=*(const LAS bf16x8*)(kp+j*2048+512); }
__device__ __forceinline__ s16x4 vtr(lds_cptr p){ return __builtin_bit_cast(s16x4,__builtin_amdgcn_ds_read_tr16_b64_v4i16((LAS v4i16_t*)p)); }
__device__ __forceinline__ float rowmax(const f32x16&p0,const f32x16&p1){
  float a=max3f(p0[0],p0[1],p1[0]),b=max3f(p0[2],p0[3],p1[1]);a=max3f(a,p1[2],p1[3]);
  #pragma unroll
  for(int r=4;r<16;r+=4){a=max3f(a,p0[r],p0[r+1]);b=max3f(b,p0[r+2],p0[r+3]);a=max3f(a,p1[r],p1[r+1]);b=max3f(b,p1[r+2],p1[r+3]);}
  const float m=max2f(a,b);
  auto rr=__builtin_amdgcn_permlane32_swap(__float_as_uint(m),__float_as_uint(m),false,false);
  return max2f(__uint_as_float(rr[0]),__uint_as_float(rr[1]));
}
__device__ __forceinline__ void pv(f32x16*o,int vb,bf16x8 pa0,bf16x8 pa1,bf16x8 pa2,bf16x8 pa3){
  #pragma unroll
  for(int d0=0;d0<2;++d0){s16x4 lo[4],hi[4];
    #pragma unroll
    for(int ks=0;ks<4;++ks){
      asm volatile("ds_read_b64_tr_b16 %0,%1 offset:%c2":"=&v"(lo[ks]):"v"(vb),"i"(d0*4096+ks*1024):"memory");
      asm volatile("ds_read_b64_tr_b16 %0,%1 offset:%c2":"=&v"(hi[ks]):"v"(vb),"i"(d0*4096+ks*1024+512):"memory");}
    asm volatile("s_waitcnt lgkmcnt(0)":::"memory");SBAR();
    #define PK(k) (bf16x8){lo[k][0],lo[k][1],lo[k][2],lo[k][3],hi[k][0],hi[k][1],hi[k][2],hi[k][3]}
    o[d0]=__builtin_amdgcn_mfma_f32_32x32x16_bf16(pa0,PK(0),o[d0],0,0,0);
    o[d0]=__builtin_amdgcn_mfma_f32_32x32x16_bf16(pa1,PK(1),o[d0],0,0,0);
    o[d0]=__builtin_amdgcn_mfma_f32_32x32x16_bf16(pa2,PK(2),o[d0],0,0,0);
    o[d0]=__builtin_amdgcn_mfma_f32_32x32x16_bf16(pa3,PK(3),o[d0],0,0,0);
    #undef PK
  }
}
__device__ __forceinline__ void bias_init(f32x16&C0,f32x16&C1,lds_cptr cl3,int T,int hi,float cqm){
  const LAS f32x4* cp=(const LAS f32x4*)(cl3+(64*T+4*hi)*4);
  #pragma unroll
  for(int g=0;g<4;++g){ const f32x4 a=cp[2*g], b=cp[2*g+8];
    #pragma unroll
    for(int i=0;i<4;++i){ C0[4*g+i]=cqm-a[i]; C1[4*g+i]=cqm-b[i]; } }
}

__device__ __forceinline__ void bias_load(f32x16&C0,f32x16&C1,lds_cptr cl3,int T,int hi){
  const LAS f32x4* cp=(const LAS f32x4*)(cl3+(64*T+4*hi)*4);
  #pragma unroll
  for(int g=0;g<4;++g){ const f32x4 a=cp[2*g], b=cp[2*g+8];
    #pragma unroll
    for(int i=0;i<4;++i){ C0[4*g+i]=a[i]; C1[4*g+i]=b[i]; } }
}
#ifndef ATTN_STORE16
#define ATTN_STORE16(p,v) (*(u32x4*)(p)=(v))
#endif
template<int THRL> __device__ __forceinline__ void attn_unit(int b,int h,int qb,const hb16*Q,const hb16*__restrict__ K,const hb16*__restrict__ V,hb16*O,char*shm,float Kb,int wave_){
  int tid=wave_*64+lane_id(); asm volatile("":"+v"(tid));
  const int lane=tid&63,r32=lane&31,hi=lane>>5; const int wid=__builtin_amdgcn_readfirstlane(tid>>6);
  const long rowbase=(long)b*SEQ; const int q0=qb*QB;
  const hb16*Qw=Q+(rowbase+q0+wid*QBLK)*QP+h*D;
  const hb16*Kh=K+rowbase*QP+h*D,*Vh=V+rowbase*QP+h*D;
  const unsigned lds0=(unsigned)(uintptr_t)shm;
  float*wsf=(float*)(shm+LDS_WS)+wid*64;
  const hb16*ksrc=Kh+(long)lane*QP+wid*8;
  const hb16*vsrc=Vh+(long)(16*(wid&3)+(lane>>2))*QP+(wid>>2)*32+(lane&3)*8;
  const unsigned kdst=lds0+LDS_K+wid*1024, vdst=lds0+LDS_V+wid*1024;
  const int NT0=(q0+QB)/KVBLK; int NT=NT0;
  #define TILE(i) (((i)<4)?(NT0-4+(i)):(NT0-1-(i)))
  #define DMA_K(t,slot) glds16(ksrc+(long)TILE(t)*KVBLK*QP,(unsigned)__builtin_amdgcn_readfirstlane(kdst+(slot)))
  #define DMA_V(t,slot) glds16(vsrc+(long)TILE(t)*KVBLK*QP,(unsigned)__builtin_amdgcn_readfirstlane(vdst+(slot)))
  const char*Kbase=shm+LDS_K; bf16x8 kf[8];
  const lds_cptr shm3=(lds_cptr)shm; const lds_cptr kp0=shm3+LDS_K+hi*1024+r32*16; const lds_cptr vp0=shm3+LDS_V+((lane>>4)&1)*32+(lane&3)*8+(4*hi+((lane&15)>>2))*64;
  const lds_cptr cl3=shm3+LDS_CL;
  DMA_K(0,0);DMA_V(0,0);DMA_K(1,SLOTB);
  bf16x8 qr[4];
  #pragma unroll
  for(int d0=0;d0<4;++d0)qr[d0]=*reinterpret_cast<const bf16x8*>(&Qw[(long)r32*QP+d0*16+hi*8]);
  const int qrel=wid*QBLK+r32;
  float mhat=0.f,l_reg=0.f;f32x16 o[2];o[0]=f32x16{};o[1]=f32x16{};
  float cqm=*(const LAS float*)(cl3+(q0+qrel)*4);
  #define CMASK(P0,P1,t) do{ if((t)<4)cmask(P0,P1,(t),qrel,hi); }while(0)
  bool resc=false;
  #define START(P0,P1) do{ const float rm=rowmax(P0,P1); resc=false; \
    { const float dl=rm; mhat=fadd_s(mhat,dl); cqm=fsub_s(cqm,dl); \
      _Pragma("unroll") for(int r=0;r<16;++r){P0[r]=fsub_s(P0[r],dl);P1[r]=fsub_s(P1[r],dl);} } \
    _Pragma("unroll") for(int r=0;r<16;++r)P0[r]=__builtin_amdgcn_exp2f(P0[r]); }while(0)
  #define RESC() do{ if(resc){ asm volatile("s_waitcnt lgkmcnt(0)":::"memory"); \
      _Pragma("unroll") for(int d_=0;d_<2;++d_) _Pragma("unroll") for(int r=0;r<16;++r)o[d_][r]*=wsf[crow(r,hi)]; } }while(0)
  f32x16 pA0,pA1,pB0,pB1;
  int sl_prev=0,sl_cur=0,sl_next=SLOTB;
  #define ROT() do{sl_prev=sl_cur;sl_cur=sl_next;sl_next=(sl_next==(NSLOT-1)*SLOTB)?0:sl_next+SLOTB;}while(0)
  DMA_K(2,2*SLOTB);
  bias_init(pA0,pA1,cl3,TILE(0),hi,cqm);
  WAIT_BAR(3);
  qkt(pA0,pA1,Kbase,qr,r32,hi);asm volatile("s_nop 15\n\ts_nop 7":"+v"(pA0),"+v"(pA1));CMASK(pA0,pA1,0);
  START(pA0,pA1);
  _Pragma("unroll") for(int r=0;r<16;++r)pA1[r]=__builtin_amdgcn_exp2f(pA1[r]);
  bias_init(pB0,pB1,cl3,TILE(1),hi,cqm);
  WAIT_BAR(0);
  DMA_K(3,0);DMA_V(1,SLOTB);
  ROT();
  kload8(kf,kp0+sl_cur);
  WAIT_BAR(2);
  s16x4 vlo[8],vhi[8]; u32x4 pw0,pw1,pw2,pw3;
  #define PKW(P,B) cvtpk_s(P[B],P[B+1])
  #define PAF(k) __builtin_bit_cast(bf16x8,pw##k)
  #define VFR(i) (bf16x8){vlo[i][0],vlo[i][1],vlo[i][2],vlo[i][3],vhi[i][0],vhi[i][1],vhi[i][2],vhi[i][3]}
  #define PIN(x) asm volatile("":"+v"(x))
  #define MX3(a,b,c) __builtin_fmaxf(__builtin_fmaxf((a),(b)),(c))
  #define GAPA(MF,A0,A1,A2,A3,W0,W1,PW) do{ MF; sacc+=A0; sacc+=A1; sacc+=A2; sacc+=A3; PIN(sacc); W0; W1; PIN(PW); SBAR(); }while(0)
  #define EX(v) __builtin_amdgcn_exp2f(v)
  #define GAPB(MF,X,B) do{ MF; X[B]=EX(X[B]); X[B+1]=EX(X[B+1]); X[B+2]=EX(X[B+2]); X[B+3]=EX(X[B+3]); PIN(X); SBAR(); }while(0)
  #define BS1(Q,i) Q[i]=cqm-Q[i]
  #define GAPBS(MF,X,B,G,Q0,i0,Q1,i1,Q2,i2,Q3,i3,Q4,i4,Q5,i5) do{ MF; X[B]=EX(X[B]); X[B+1]=EX(X[B+1]); X[B+2]=EX(X[B+2]); X[B+3]=EX(X[B+3]); PIN(X); \
      if(G){ BS1(Q0,i0); BS1(Q1,i1); BS1(Q2,i2); BS1(Q3,i3); BS1(Q4,i4); if((i5)!=(i4)){BS1(Q5,i5);} PIN(Q0); PIN(Q5); } SBAR(); }while(0)
  #define VRD(i) do{ vlo[i]=vtr(vp_+(((i)>>2)*4096+((i)&3)*1024)); vhi[i]=vtr(vp_+(((i)>>2)*4096+((i)&3)*1024+512)); }while(0)
  #define KRD(G,j) do{ if(G){ kload2(kf,kp0+sl_next,j); SBAR(); } }while(0)
  #define STEP(C0,C1,P0,P1,t,GK,GV,GL) do{ SBAR(); \
    const lds_cptr vp_=vp0+sl_prev; \
    VRD(0); SBAR(); float sacc=(P0[0]+P0[1]); \
    GAPA(C0=__builtin_amdgcn_mfma_f32_32x32x16_bf16(kf[0],qr[0],C0,0,0,0), P0[2],P0[3],P0[4],P0[5],     pw0[0]=PKW(P0,0), pw0[1]=PKW(P0,2), pw0); \
    VRD(4); SBAR(); GAPA(C1=__builtin_amdgcn_mfma_f32_32x32x16_bf16(kf[1],qr[0],C1,0,0,0), P0[6],P0[7],P0[8],P0[9],     pw0[2]=PKW(P0,4), pw0[3]=PKW(P0,6), pw0); \
    VRD(1); SBAR(); GAPA(C0=__builtin_amdgcn_mfma_f32_32x32x16_bf16(kf[2],qr[1],C0,0,0,0),   P0[10],P0[11],P0[12],P0[13], pw1[0]=PKW(P0,8), pw1[1]=PKW(P0,10), pw1); \
    VRD(5); SBAR(); GAPA(C1=__builtin_amdgcn_mfma_f32_32x32x16_bf16(kf[3],qr[1],C1,0,0,0),   P0[14],P0[15],P1[0],P1[1],   pw1[2]=PKW(P0,12),pw1[3]=PKW(P0,14), pw1); \
    VRD(2); SBAR(); GAPA(C0=__builtin_amdgcn_mfma_f32_32x32x16_bf16(kf[4],qr[2],C0,0,0,0),   P1[2],P1[3],P1[4],P1[5],     pw2[0]=PKW(P1,0), pw2[1]=PKW(P1,2), pw2); \
    VRD(6); SBAR(); GAPA(C1=__builtin_amdgcn_mfma_f32_32x32x16_bf16(kf[5],qr[2],C1,0,0,0),   P1[6],P1[7],P1[8],P1[9],     pw2[2]=PKW(P1,4), pw2[3]=PKW(P1,6), pw2); \
    VRD(3); SBAR(); GAPA(C0=__builtin_amdgcn_mfma_f32_32x32x16_bf16(kf[6],qr[3],C0,0,0,0),   P1[10],P1[11],P1[12],P1[13], pw3[0]=PKW(P1,8), pw3[1]=PKW(P1,10), pw3); \
    VRD(7); SBAR(); GAPA(C1=__builtin_amdgcn_mfma_f32_32x32x16_bf16(kf[7],qr[3],C1,0,0,0),   P1[14],P1[15],0.f,0.f,       pw3[2]=PKW(P1,12),pw3[3]=PKW(P1,14), pw3); \
    l_reg+=sacc; \
    if(GK){DMA_K((t)+3,sl_cur);} if(GV){DMA_V((t)+1,sl_next);} \
    CMASK(C0,C1,t); \
    { float a=MX3(C0[0],C0[1],C1[0]),b=MX3(C0[2],C0[3],C1[1]); a=MX3(a,C1[2],C1[3]); \
      _Pragma("unroll") for(int r=4;r<16;r+=4){a=MX3(a,C0[r],C0[r+1]);b=MX3(b,C0[r+2],C0[r+3]);a=MX3(a,C1[r],C1[r+1]);b=MX3(b,C1[r+2],C1[r+3]);} \
      float rm=__builtin_fmaxf(a,b); { auto rr=__builtin_amdgcn_permlane32_swap(__float_as_uint(rm),__float_as_uint(rm),false,false); rm=__builtin_fmaxf(__uint_as_float(rr[0]),__uint_as_float(rr[1])); } \
      resc=false; \
      if(__builtin_expect(__any(rm>(float)THRL),0)){ const float dl=__builtin_fmaxf(rm,0.f); mhat+=dl; cqm-=dl; \
        _Pragma("unroll") for(int r=0;r<16;++r){C0[r]-=dl;C1[r]-=dl;} \
        const float f=__builtin_amdgcn_exp2f(-dl); l_reg*=f; { int r_=r32; asm volatile("":"+v"(r_)); if(hi==0)wsf[r_]=f; } resc=true; } } \
    SBAR(); \
    if(GL){ bias_load(P0,P1,cl3,TILE((t)+1),hi); } SBAR(); \
    GAPB(o[0]=__builtin_amdgcn_mfma_f32_32x32x16_bf16(PAF(0),VFR(0),o[0],0,0,0), C0,0); \
    GAPB(o[1]=__builtin_amdgcn_mfma_f32_32x32x16_bf16(PAF(0),VFR(4),o[1],0,0,0), C0,4); \
    KRD(GL,0); GAPBS(o[0]=__builtin_amdgcn_mfma_f32_32x32x16_bf16(PAF(1),VFR(1),o[0],0,0,0), C0,8,  GL,P0,0,P0,1,P0,2,P0,3,P0,4,P0,5); \
    KRD(GL,1); GAPBS(o[1]=__builtin_amdgcn_mfma_f32_32x32x16_bf16(PAF(1),VFR(5),o[1],0,0,0), C0,12, GL,P0,6,P0,7,P0,8,P0,9,P0,10,P0,11); \
    KRD(GL,2); GAPBS(o[0]=__builtin_amdgcn_mfma_f32_32x32x16_bf16(PAF(2),VFR(2),o[0],0,0,0), C1,0,  GL,P0,12,P0,13,P0,14,P0,15,P1,0,P1,0); \
    KRD(GL,3); GAPBS(o[1]=__builtin_amdgcn_mfma_f32_32x32x16_bf16(PAF(2),VFR(6),o[1],0,0,0), C1,4,  GL,P1,1,P1,2,P1,3,P1,4,P1,5,P1,5); \
    GAPBS(o[0]=__builtin_amdgcn_mfma_f32_32x32x16_bf16(PAF(3),VFR(3),o[0],0,0,0), C1,8,  GL,P1,6,P1,7,P1,8,P1,9,P1,10,P1,10); \
    GAPBS(o[1]=__builtin_amdgcn_mfma_f32_32x32x16_bf16(PAF(3),VFR(7),o[1],0,0,0), C1,12, GL,P1,11,P1,12,P1,13,P1,14,P1,15,P1,15); \
    }while(0)
  #define ENDW(tt) do{ if((tt)+3<NT){WAIT_BAR(2);} else if((tt)+2<NT){WAIT_BAR(1);} else {WAIT_BAR(0);} }while(0)
  int t;
  for(t=1;t<5&&t+1<NT;t+=2){
    STEP(pB0,pB1,pA0,pA1,t,(t+3<NT),(t+1<NT),(t+1<NT));       ENDW(t);   RESC(); ROT();
    if(t==3)
    {  float bqk;
      { float qs=0.f;
        #pragma unroll
        for(int d0=0;d0<4;++d0){
          #pragma unroll
          for(int j=0;j<8;++j){const float v=__uint_as_float(((unsigned)(unsigned short)qr[d0][j])<<16);qs+=v*v;} }
        auto rr=__builtin_amdgcn_permlane32_swap(__float_as_uint(qs),__float_as_uint(qs),false,false);
        bqk=__builtin_amdgcn_sqrtf(__uint_as_float(rr[0])+__uint_as_float(rr[1]))*1.0001f*Kb; }

      const float X=cqm+bqk+(float)(SKIP+THRL);
      int lo=0,hi_=NT0-4;
      while(lo<hi_){ const int mid=(lo+hi_)>>1; const float c=*(const LAS float*)(cl3+(64*mid+63)*4); if(c<=X)hi_=mid; else lo=mid+1; }
      #pragma unroll
      for(int o_=1;o_<64;o_<<=1){ const int u_=shx_i(lo,o_); lo=u_<lo?u_:lo; }
      if(lane==0)*(LAS int*)(cl3+SEQ*4+wid*4)=lo; }
    STEP(pA0,pA1,pB0,pB1,t+1,(t+4<NT),(t+2<NT),(t+2<NT));     ENDW(t+1); RESC(); ROT();
  }
  if(NT0>4)
    { int tm=NT0;
      #pragma unroll
      for(int w=0;w<8;++w){ const int v_=*(const LAS int*)(cl3+SEQ*4+w*4); tm=v_<tm?v_:tm; }
      tm=__builtin_amdgcn_readfirstlane(tm);
      int ne=4+((NT0-4-tm)>0?(NT0-4-tm):0); ne=ne<8?8:ne; ne=(ne+1)&~1; NT=ne<NT0?ne:NT0; }
  #undef CMASK
  #define CMASK(P0,P1,t) do{}while(0)
  for(;t+5<NT;t+=2){
    STEP(pB0,pB1,pA0,pA1,t,true,true,true);     WAIT_BAR(2); RESC(); ROT();
    STEP(pA0,pA1,pB0,pB1,t+1,true,true,true);   WAIT_BAR(2); RESC(); ROT();
  }
  for(;t+1<NT;t+=2){
    STEP(pB0,pB1,pA0,pA1,t,(t+3<NT),(t+1<NT),(t+1<NT));       ENDW(t);   RESC(); ROT();
    STEP(pA0,pA1,pB0,pB1,t+1,(t+4<NT),(t+2<NT),(t+2<NT));     ENDW(t+1); RESC(); ROT();
  }
  #undef CMASK
  #define CMASK(P0,P1,t) do{ if((t)<4)cmask(P0,P1,(t),qrel,hi); }while(0)
  STEP(pB0,pB1,pA0,pA1,NT-1,false,false,false); RESC();
  { float sacc=pB0[0]+pB0[1]; _Pragma("unroll") for(int r=2;r<16;++r)sacc+=pB0[r]; _Pragma("unroll") for(int r=0;r<16;++r)sacc+=pB1[r]; l_reg+=sacc;
    pw0=(u32x4){PKW(pB0,0),PKW(pB0,2),PKW(pB0,4),PKW(pB0,6)};pw1=(u32x4){PKW(pB0,8),PKW(pB0,10),PKW(pB0,12),PKW(pB0,14)};pw2=(u32x4){PKW(pB1,0),PKW(pB1,2),PKW(pB1,4),PKW(pB1,6)};pw3=(u32x4){PKW(pB1,8),PKW(pB1,10),PKW(pB1,12),PKW(pB1,14)};
    const int vb0=(int)(lds0+LDS_V)+((lane>>4)&1)*32+(lane&3)*8+(4*hi+((lane&15)>>2))*64;
    SBAR(); pv(o,vb0+sl_cur,PAF(0),PAF(1),PAF(2),PAF(3)); }
  #undef PKW
  #undef PAF
  #undef VFR
  #undef PIN
  #undef MX3
  #undef GAPA
  #undef GAPB
  #undef EX
  #undef VRD
  #undef KRD
  #undef STEP
  #undef ENDW
  {auto rr=__builtin_amdgcn_permlane32_swap(__float_as_uint(l_reg),__float_as_uint(l_reg),false,false);l_reg=__uint_as_float(rr[0])+__uint_as_float(rr[1]);}
  if(hi==0)wsf[32+r32]=l_reg;asm volatile("s_waitcnt lgkmcnt(0)":::"memory");
  float rli[16];
  #pragma unroll
  for(int r=0;r<16;++r)rli[r]=__builtin_amdgcn_rcpf(wsf[32+crow(r,hi)]);
  hb16*Ow=O+(rowbase+q0+wid*QBLK)*OP+h*D;
  { hb16*stg=(hb16*)(shm+LDS_OST)+wid*2048;
    #pragma unroll
    for(int r=0;r<16;++r){const int orow=crow(r,hi);
      #pragma unroll
      for(int d0=0;d0<2;++d0)stg[orow*64+d0*32+r32]=__float2bfloat16(o[d0][r]*rli[r]);}
    asm volatile("s_waitcnt lgkmcnt(0)":::"memory");
    #pragma unroll
    for(int i=0;i<4;++i){const int row=i*8+(lane>>3),ch=lane&7; const u32x4 v=*(const u32x4*)(stg+row*64+ch*8);
#if MK_MIX8
      { unsigned char*O8=(unsigned char*)O+(size_t)(rowbase+q0+wid*QBLK+row)*OP+h*D+ch*8;
        v2u w8; w8.x=pg8::pk4_fp8(bf2f(v.x&0xffffu)*MIX_SCALE,bf2f(v.x>>16)*MIX_SCALE,bf2f(v.y&0xffffu)*MIX_SCALE,bf2f(v.y>>16)*MIX_SCALE); w8.y=pg8::pk4_fp8(bf2f(v.z&0xffffu)*MIX_SCALE,bf2f(v.z>>16)*MIX_SCALE,bf2f(v.w&0xffffu)*MIX_SCALE,bf2f(v.w>>16)*MIX_SCALE);
        *(GAS v2u*)O8=w8; }
#else
      ATTN_STORE16(Ow+(long)row*OP+ch*8,v);
#endif
    } }
  asm volatile("s_waitcnt lgkmcnt(0)\n\ts_barrier":::"memory");
  #undef DMA_K
  #undef DMA_V
  #undef TILE
  #undef CMASK
  #undef START
  #undef RESC
  #undef ROT
}
__device__ __forceinline__ void fox_cumsum(const float*logf,int b,int h,char*shm,int wave_){
  int tid=wave_*64+lane_id(); asm volatile("":"+v"(tid));
  const int lane=tid&63,wid=tid>>6;
  LAS float*cl=(LAS float*)((lds_cptr)shm+LDS_CL); LAS float*tmp=(LAS float*)((lds_cptr)shm+LDS_CLTMP);
  float v[8];
  #pragma unroll
  for(int i=0;i<8;++i)v[i]=logf[((size_t)b*SEQ+8*tid+i)*FH+h];
  #pragma unroll
  for(int i=1;i<8;++i)v[i]+=v[i-1];
  const float tot=v[7]; float s=tot;
  #pragma unroll
  for(int o=1;o<64;o<<=1){const float u=shup_f(s,o); if(lane>=o)s+=u;}
  __syncthreads();
  if(lane==63)tmp[wid]=s;
  __syncthreads();
  float base=0.f;
  for(int w=0;w<wid;++w)base+=tmp[w];
  const float excl=base+s-tot;
  #pragma unroll
  for(int i=0;i<8;++i)cl[8*tid+i]=(excl+v[i])*LOG2E;
  __syncthreads();
}
#undef SBAR
#undef WAIT_BAR
}
#define XB_TMO      128
#define XB_XCNT(j)  (256  + 64 * (j))
#define XB_XSUB(j)  (1280 + 64 * (j))
#define XB_XGEN(j)  (2304 + 64 * (j))
#define XB_TOP      3328
#define XB_TOPGEN   3392
#define XCD_BAR_WORDS 3456
#define XB_SPIN_CAP (1u << 18)

__device__ __forceinline__ unsigned xb_ld(unsigned* p)              { return __hip_atomic_load(p, __ATOMIC_RELAXED, __HIP_MEMORY_SCOPE_AGENT); }
__device__ __forceinline__ unsigned xb_add(unsigned* p, unsigned v) { return __hip_atomic_fetch_add(p, v, __ATOMIC_RELAXED, __HIP_MEMORY_SCOPE_AGENT); }
__device__ __forceinline__ unsigned xb_xcc_id() { return (unsigned)__builtin_amdgcn_s_getreg((3 << 11) | 20) & 0xFu; }
#ifndef MK_BARNAP
#define MK_BARNAP 0
#endif
#if MK_BARNAP
#define XB_NAP() __builtin_amdgcn_s_sleep(1)
#else
#define XB_NAP() do {} while (0)
#endif
#define XB_SPIN(cond, bar) do { unsigned _sp = 0; while (cond) { XB_NAP(); \
    if ((++_sp & 255u) == 0u) { if (xb_ld(&(bar)[XB_TMO])) break; if (_sp > XB_SPIN_CAP) { atomicAdd(&(bar)[XB_TMO], 1u); break; } } } } while (0)

struct XcdBarrier {
    unsigned w0;
    unsigned* bar; unsigned x;
    volatile LAS unsigned* st;
};

__device__ __forceinline__ XcdBarrier xcd_barrier_post(unsigned* bar, volatile LAS unsigned* st, unsigned w0) {
    XcdBarrier b; b.w0 = w0; b.bar = bar; b.x = xb_xcc_id(); b.st = st;
    if (w0 && lane_id() == 0) (void)xb_add(&bar[XB_XCNT(b.x)], 1u);
    return b;
}
__device__ __forceinline__ void xcd_barrier_complete(unsigned* bar, unsigned x, unsigned& nloc, unsigned& nx) {
    const unsigned G = gridDim.x * gridDim.y * gridDim.z;
    unsigned sum, cnt, mine, sp = 0u;
    for (;;) {
        sum = 0u; cnt = 0u; mine = 0u;
#pragma unroll
        for (unsigned j = 0; j < 16; ++j) { const unsigned c = xb_ld(&bar[XB_XCNT(j)]); sum += c; cnt += (c > 0u) ? 1u : 0u; }
        if (sum == G) { mine = xb_ld(&bar[XB_XCNT(x)]); break; }
        __builtin_amdgcn_s_sleep(1);
        if ((++sp & 255u) == 0u) { if (xb_ld(&bar[XB_TMO])) break; if (sp > XB_SPIN_CAP) { atomicAdd(&bar[XB_TMO], 1u); break; } }
    }
    nloc = mine > 0u ? mine : 1u; nx = cnt > 0u ? cnt : 1u;
}

__device__ __forceinline__ void xcd_barrier(const XcdBarrier& b) {
    asm volatile("s_waitcnt vmcnt(0)" ::: "memory");
    __syncthreads();
    if (b.w0 && lane_id() == 0) {
        unsigned* bar = b.bar; asm volatile("" : "+s"(bar));
        __builtin_amdgcn_s_waitcnt(0);
        unsigned nloc = b.st[0], nx = b.st[1];
        if (nloc == 0u) { xcd_barrier_complete(bar, b.x, nloc, nx); b.st[0] = nloc; b.st[1] = nx; }
        const unsigned old = xb_add(&bar[XB_XSUB(b.x)], 1u);
        const unsigned gen = old / nloc;
        if (old + 1u == (gen + 1u) * nloc) {
            __builtin_amdgcn_fence(__ATOMIC_RELEASE, "agent");
            asm volatile("s_waitcnt vmcnt(0)" ::: "memory");
            const unsigned og = xb_add(&bar[XB_TOP], 1u);
            const unsigned tg = og / nx;
            if (og + 1u == (tg + 1u) * nx) xb_add(&bar[XB_TOPGEN], 1u);
            else XB_SPIN(xb_ld(&bar[XB_TOPGEN]) == tg, bar);
            __builtin_amdgcn_fence(__ATOMIC_ACQUIRE, "agent");
            xb_add(&bar[XB_XGEN(b.x)], 1u);
            asm volatile("s_waitcnt vmcnt(0)" ::: "memory");
        } else {
            XB_SPIN(xb_ld(&bar[XB_XGEN(b.x)]) == gen, bar);
            __builtin_amdgcn_fence(__ATOMIC_ACQUIRE, "agent");
            asm volatile("s_waitcnt vmcnt(0)" ::: "memory");
        }
    }
    __syncthreads();
}
struct Frame {
    LAS unsigned char* lds;
    volatile LAS unsigned* MISC;
    gu32* ctl;
    int tid, lane, wave;
    int vcu, G;
    float* out; unsigned char* ws;
};
enum { I_X = 0, I_NMIX, I_WIN, I_FB, I_WOUT, I_NFFN, I_WRG, I_BRG, I_WRE, I_BRE, I_WEG, I_WEU, I_WED, I_NFIN };

__device__ __forceinline__ void p0_item(const float* W, int pitch, int k0, int c0, bf16* WT, int Kd, int drow0, int dmul, LAS float* scr, int lane) {
    const int lc = 4 * (lane & 15), lr = lane >> 4;
    f32x4 v[16];
#pragma unroll
    for (int i = 0; i < 16; ++i) v[i] = *(const GAS f32x4*)(W + (size_t)(k0 + lr + 4 * i) * pitch + c0 + lc);
#pragma unroll
    for (int i = 0; i < 16; ++i) { LAS float* s = scr + (lr + 4 * i) * 65 + lc; s[0] = v[i].x; s[1] = v[i].y; s[2] = v[i].z; s[3] = v[i].w; }
    LDS_WAIT(); asm volatile("" ::: "memory");
    const int c = lane & 7;
#pragma unroll
    for (int j = 0; j < 8; ++j) { const int n = (lane >> 3) + 8 * j; const LAS float* s = scr + (8 * c) * 65 + n;
        v4u o; o.x = pk2(s[0 * 65], s[1 * 65]); o.y = pk2(s[2 * 65], s[3 * 65]); o.z = pk2(s[4 * 65], s[5 * 65]); o.w = pk2(s[6 * 65], s[7 * 65]);
        *(GAS v4u*)(WT + (size_t)(drow0 + n * dmul) * Kd + k0 + 8 * c) = o; }
    LDS_WAIT(); asm volatile("" ::: "memory");
}
constexpr float W8_SCALE = 32.f, W8_INV = 1.f / 32.f;
__device__ __forceinline__ void p0_item8(const float* W, int pitch, int k0, int c0, unsigned char* WT8, int Kd, int drow0, LAS float* scr, int lane) {
    const int lc = 4 * (lane & 15), lr = lane >> 4;
    f32x4 v[16];
#pragma unroll
    for (int i = 0; i < 16; ++i) v[i] = *(const GAS f32x4*)(W + (size_t)(k0 + lr + 4 * i) * pitch + c0 + lc);
#pragma unroll
    for (int i = 0; i < 16; ++i) { LAS float* s = scr + (lr + 4 * i) * 65 + lc; s[0] = v[i].x; s[1] = v[i].y; s[2] = v[i].z; s[3] = v[i].w; }
    LDS_WAIT(); asm volatile("" ::: "memory");
    const int c = lane & 7;
#pragma unroll
    for (int j = 0; j < 8; ++j) { const int n = (lane >> 3) + 8 * j; const LAS float* s = scr + (8 * c) * 65 + n;
        v2u o; o.x = pg8::pk4_fp8(s[0 * 65] * W8_SCALE, s[1 * 65] * W8_SCALE, s[2 * 65] * W8_SCALE, s[3 * 65] * W8_SCALE); o.y = pg8::pk4_fp8(s[4 * 65] * W8_SCALE, s[5 * 65] * W8_SCALE, s[6 * 65] * W8_SCALE, s[7 * 65] * W8_SCALE);
        *(GAS v2u*)(WT8 + (size_t)(drow0 + n) * Kd + k0 + 8 * c) = o; }
    LDS_WAIT(); asm volatile("" ::: "memory");
}
__device__ __forceinline__ void sincos_d(double a, double& s, double& c) {
    const double kd = rint(a * 0.6366197723675814);
    double r = fma(-kd, 1.5707963267948966, a); r = fma(-kd, 6.123233995736766e-17, r);
    const int q = (int)((long long)kd & 3);
    const double r2 = r * r;
    const double sp = r * (1.0 + r2 * (-1.0 / 6 + r2 * (1.0 / 120 + r2 * (-1.0 / 5040 + r2 * (1.0 / 362880 + r2 * (-1.0 / 39916800 + r2 * (1.0 / 6227020800.0)))))));
    const double cp = 1.0 + r2 * (-0.5 + r2 * (1.0 / 24 + r2 * (-1.0 / 720 + r2 * (1.0 / 40320 + r2 * (-1.0 / 3628800 + r2 * (1.0 / 479001600 + r2 * (-1.0 / 87178291200.0)))))));
    s = (q == 0) ? sp : (q == 1) ? cp : (q == 2) ? -sp : -cp;
    c = (q == 0) ? cp : (q == 1) ? -sp : (q == 2) ? -cp : sp;
}
constexpr int IT_WIN = 56 * 16, IT_WOUT = 16 * 16, IT_G = 32 * 8 * 16, IT_D = 32 * 16 * 8, IT_LAYER = IT_WIN + IT_WOUT + 2 * IT_G + IT_D;
__device__ __forceinline__ void p0_do_item(Frame& F, int l, int r, const float* w_in, const float* w_out, const float* w_eg, const float* w_eu, const float* w_ed, LAS float* scr) {
    if (r < IT_WIN) { const int kb = r / 56, cb = r % 56, kind = cb >> 3, j = cb & 7;
        int c0, d0, dm = 1;
        if (kind == 0) { c0 = SRC_FQ + 64 * j; d0 = PQ + 64 * j; }
        else if (kind == 1) { c0 = SRC_FK + 64 * j; d0 = PK + 64 * j; }
        else if (kind == 2) { c0 = SRC_FV + 64 * j; d0 = PV + 64 * j; }
        else if (kind == 3) { c0 = SRC_RQ + 64 * j; d0 = PRQ + 128 * (j >> 1) + (j & 1); dm = 2; }
        else if (kind == 4) { c0 = SRC_RK + 64 * j; d0 = PRK + 128 * (j >> 1) + (j & 1); dm = 2; }
        else if (kind == 5) { c0 = SRC_RV + 64 * j; d0 = PRV + 64 * j; }
        else { c0 = SRC_RG + 64 * j; d0 = PRG + 64 * j; }
        p0_item(w_in + (size_t)l * DM * INW, INW, 64 * kb, c0, (bf16*)(F.ws + WS_WIN) + (size_t)l * NPROJ * DM, DM, d0, dm, scr, F.lane); return; }
    r -= IT_WIN;
    if (r < IT_WOUT) { const int kb = r / 16, cb = r % 16;
        if (MK_MIX8) p0_item8(w_out + (size_t)l * DM * DM, DM, 64 * kb, 64 * cb, F.ws + WS_WOUT + (size_t)l * DM * DM, DM, 64 * cb, scr, F.lane);
        else p0_item(w_out + (size_t)l * DM * DM, DM, 64 * kb, 64 * cb, (bf16*)(F.ws + WS_WOUT) + (size_t)l * DM * DM, DM, 64 * cb, 1, scr, F.lane);
        return; }
    r -= IT_WOUT;
    if (r < 2 * IT_G) { const int up = r >= IT_G; if (up) r -= IT_G; const int e = r / 128, q = r % 128, kb = q / 8, cb = q % 8, n0 = 64 * cb;
        if (MK_FP8) p0_item8((up ? w_eu : w_eg) + (size_t)(l * NE + e) * DM * DE, DE, 64 * kb, n0, F.ws + WS_W1 + (size_t)(l * NE + e) * 1024 * 1024, 1024, 256 * (n0 >> 7) + (n0 & 127) + (up ? 128 : 0), scr, F.lane);
        else p0_item((up ? w_eu : w_eg) + (size_t)(l * NE + e) * DM * DE, DE, 64 * kb, n0, (bf16*)(F.ws + WS_W1) + (size_t)(l * NE + e) * 1024 * 1024, 1024, 256 * (n0 >> 7) + (n0 & 127) + (up ? 128 : 0), 1, scr, F.lane);
        return; }
    r -= 2 * IT_G;
    { const int e = r / 128, q = r % 128, kb = q / 16, cb = q % 16;
        if (MK_FP8) p0_item8(w_ed + (size_t)(l * NE + e) * DE * DM, DM, 64 * kb, 64 * cb, F.ws + WS_W2 + (size_t)(l * NE + e) * 1024 * DE, DE, 64 * cb, scr, F.lane);
        else p0_item(w_ed + (size_t)(l * NE + e) * DE * DM, DM, 64 * kb, 64 * cb, (bf16*)(F.ws + WS_W2) + (size_t)(l * NE + e) * 1024 * DE, DE, 64 * cb, 1, scr, F.lane); }
}
constexpr int IT_DENSE = IT_WIN + IT_WOUT, IT_EXP = 2 * IT_G + IT_D;
constexpr int CVT_UNITS = 64, CVT_PER_UNIT = IT_EXP / CVT_UNITS;
static_assert(IT_EXP % CVT_UNITS == 0 && CVT_PER_UNIT % NWAVES == 0, "conversion units");
__device__ __forceinline__ void p0_prologue(Frame& F, const float* w_in, const float* w_out, const float* w_eg, const float* w_eu, const float* w_ed, const float* wrg, const float* wre) {
    LAS float* scr = (LAS float*)(F.lds) + F.wave * (64 * 65);
    const int gw = F.vcu * NWAVES + F.wave, NGW = F.G * NWAVES;
    for (int it = gw; it < IT_DENSE; it += NGW) p0_do_item(F, 0, it, w_in, w_out, w_eg, w_eu, w_ed, scr);
    for (int q = F.vcu * NTHREADS + F.tid; q < DEPTH * RFR_N; q += F.G * NTHREADS) { const int l = q / RFR_N, qq = q % RFR_N, s_ = qq / 192, nt = (qq / 64) % 3, ln = qq & 63, col = 16 * nt + (ln & 15), k0 = 32 * s_ + 8 * (ln >> 4);
        float w[8];
#pragma unroll
        for (int j = 0; j < 8; ++j) w[j] = (col < NG) ? wrg[(size_t)l * DM * NG + (size_t)(k0 + j) * NG + col] : (col < NG + NE) ? wre[(size_t)l * DM * NE + (size_t)(k0 + j) * NE + col - NG] : 0.f;
        ((v4u*)(F.ws + WS_RFR))[q] = (v4u){pk2(w[0], w[1]), pk2(w[2], w[3]), pk2(w[4], w[5]), pk2(w[6], w[7])}; }
    for (int q = F.vcu * NTHREADS + F.tid; q < DEPTH * 4096; q += F.G * NTHREADS) { const int l = q >> 12, ln = (q >> 6) & 63, d = q & 63, j = d >> 4, p_ = (d >> 3) & 1, h = d & 7;
        const float* p0 = w_in + (size_t)l * DM * INW + (size_t)(4 * ln + 256 * j + 2 * p_) * INW + SRC_FF + h;
        ((unsigned*)(F.ws + WS_WFP))[(size_t)l * 4096 + ((d >> 2) * 64 + ln) * 4 + (d & 3)] = pk2(p0[0], p0[INW]); }
    f32x2* rot = (f32x2*)(F.ws + WS_ROT);
    for (int idx = F.vcu * NTHREADS + F.tid; idx < SEQ * 64; idx += F.G * NTHREADS) {
        const int pos = idx >> 6, i = idx & 63;
        const float inv = 1.0f / powf(10000.0f, (float)i / 64.0f);
        const float ang = (float)pos * inv;
        double s, c; sincos_d((double)ang, s, c);
        rot[idx] = (f32x2){(float)c, (float)s};
    }
}

#ifndef MK_REDEAL
#define MK_REDEAL 2
#endif
constexpr int AUX_U2 = 3712;
constexpr int AUX_TS = 0, AUX_CNT = 64, AUX_U = 96, AUX_TOK = 128, AUX_MAXU = 14;
__device__ __forceinline__ void moe_table(Frame& F, int layer) {
    LAS int* aux = (LAS int*)(F.lds + AUX_OFF);
    __syncthreads();
    if (F.tid < 32) aux[AUX_CNT + F.tid] = (int)__hip_atomic_load(F.ctl + CW_CNT + layer * 32 + F.tid, RLX_AGENT);
    __syncthreads();
    if (F.tid == 0) { int s = 0; for (int e = 0; e < 32; ++e) { aux[AUX_TS + e] = s; s += (aux[AUX_CNT + e] + 255) >> 8; } aux[AUX_TS + 32] = s; }
    __syncthreads();
    if (F.tid < 16) { const int mt = (F.tid * F.G + F.vcu) >> 2; int e = -1, ml = 0;
        if (mt < aux[AUX_TS + 32]) { e = 0; while (aux[AUX_TS + e + 1] <= mt) ++e; ml = mt - aux[AUX_TS + e]; }
        aux[AUX_U + 2 * F.tid] = e; aux[AUX_U + 2 * F.tid + 1] = ml; }
    if (F.tid >= 32 && F.tid < 48) {
        const int j = F.tid - 32, T = aux[AUX_TS + 32], U = 4 * T, r1 = U % F.G, E = r1 ? F.G - r1 : 0, c = F.vcu;
        int L2;
        if (!MK_CHAIN || r1 == 0) L2 = j * F.G + c;
        else if (c >= r1) L2 = j < MK_REDEAL ? j * E + (c - r1) : MK_REDEAL * E + (j - MK_REDEAL) * F.G + c;
        else L2 = MK_REDEAL * E + j * F.G + c;
        int e = -1, ml = 0; const int mt = L2 >> 2;
        if (L2 < U) { e = 0; while (aux[AUX_TS + e + 1] <= mt) ++e; ml = mt - aux[AUX_TS + e]; }
        aux[AUX_U2 + 4 * j] = e; aux[AUX_U2 + 4 * j + 1] = ml; aux[AUX_U2 + 4 * j + 2] = mt; aux[AUX_U2 + 4 * j + 3] = L2 & 3; }
    __syncthreads();
}

typedef __bf16 bf16x2v __attribute__((ext_vector_type(2)));
#ifndef MK_WT
#define MK_WT 1
#endif
#if MK_WT
#define ST_WT8(p, lo, hi) __hip_atomic_store((GAS unsigned long long*)(p), ((unsigned long long)(hi) << 32) | (unsigned long long)(lo), RLX_AGENT)
#else
#define ST_WT8(p, lo, hi) (*(GAS v2u*)(p) = (v2u){(lo), (hi)})
#endif
template <bool COMBINE, bool FINAL>
__device__ __forceinline__ void pa_row(Frame& F, const f32x4 (&v)[4], const int m, float* xout, const f32x4 (&nw)[4], const unsigned (&wfp)[4][2][8], const float* fb, const int lane) {
        float s = 0.f;
#pragma unroll
        for (int j = 0; j < 4; ++j) s += (v[j].x * v[j].x + v[j].y * v[j].y) + (v[j].z * v[j].z + v[j].w * v[j].w);
        const float rstd = __builtin_amdgcn_rsqf(wave_sum(s) * (1.f / DM) + eps_s());
        if (FINAL) {
#pragma unroll
            for (int j = 0; j < 4; ++j) *(GAS f32x4*)(xout + (size_t)m * DM + 4 * lane + 256 * j) = v[j] * rstd * nw[j];
        } else {
            if (COMBINE) {
                bf16* xb = (bf16*)(F.ws + WS_XB) + (size_t)m * DM;
#pragma unroll
                for (int j = 0; j < 4; ++j) ST_WT8(xb + 4 * lane + 256 * j, pk2(v[j].x, v[j].y), pk2(v[j].z, v[j].w));
            }
            float fa[8];
#pragma unroll
            for (int h = 0; h < 8; ++h) fa[h] = 0.f;
            bf16* hn = (bf16*)(F.ws + WS_HN) + (size_t)m * DM;
#pragma unroll
            for (int j = 0; j < 4; ++j) { const f32x4 hv = v[j] * rstd * nw[j];
                const unsigned h0 = pk2(hv.x, hv.y), h1 = pk2(hv.z, hv.w);
                ST_WT8(hn + 4 * lane + 256 * j, h0, h1);
#pragma unroll
                for (int h = 0; h < 8; ++h) { fa[h] = __builtin_amdgcn_fdot2_f32_bf16(__builtin_bit_cast(bf16x2v, h0), __builtin_bit_cast(bf16x2v, wfp[j][0][h]), fa[h], false);
                    fa[h] = __builtin_amdgcn_fdot2_f32_bf16(__builtin_bit_cast(bf16x2v, h1), __builtin_bit_cast(bf16x2v, wfp[j][1][h]), fa[h], false); } }
            float zt;
            { const bool b0 = (lane & 1) != 0, b1 = (lane & 2) != 0, b2 = (lane & 4) != 0; float t4[4], t2[2];
#pragma unroll
              for (int j = 0; j < 4; ++j) { const float snd = b0 ? fa[2 * j] : fa[2 * j + 1], kp = b0 ? fa[2 * j + 1] : fa[2 * j]; t4[j] = kp + shx_f(snd, 1); }
#pragma unroll
              for (int j = 0; j < 2; ++j) { const float snd = b1 ? t4[2 * j] : t4[2 * j + 1], kp = b1 ? t4[2 * j + 1] : t4[2 * j]; t2[j] = kp + shx_f(snd, 2); }
              { const float snd = b2 ? t2[0] : t2[1], kp = b2 ? t2[1] : t2[0]; zt = kp + shx_f(snd, 4); }
              zt += shx_f(zt, 8); zt += shx_f(zt, 16); zt += shx_f(zt, 32); }
            if (lane < 8) { float z = zt;
                z += fb[lane];
                float ln2_ = 0.6931471805599453f; asm volatile("" : "+v"(ln2_));
                const float lf = fminf(z, 0.f) - ln2_ * __builtin_amdgcn_logf(1.f + __builtin_amdgcn_exp2f(-1.4426950408889634f * fabsf(z)));
                ((float*)(F.ws + WS_LOGF))[(size_t)m * FH + lane] = lf; }
        }
}
template <bool COMBINE, bool FINAL>
__device__ __forceinline__ void pa_phase(Frame& F, const float* xin, float* xout, const float* normw, const int wfp_layer, const float* win0, const float* fb, int prev_layer) {
    const int gw = F.vcu * NWAVES + F.wave, NGW = F.G * NWAVES, lane = F.lane;
    LAS int* aux = (LAS int*)(F.lds + AUX_OFF);
    if (COMBINE && MK_MULTI) moe_table(F, prev_layer);
    f32x4 nw[4];
#pragma unroll
    for (int j = 0; j < 4; ++j) nw[j] = *(const GAS f32x4*)(normw + 4 * lane + 256 * j);
    unsigned wfp[4][2][8];
    if (!FINAL && COMBINE) { const v4u* wp = (const v4u*)(F.ws + WS_WFP) + (size_t)wfp_layer * 1024 + lane;
#pragma unroll
        for (int v = 0; v < 16; ++v) { const v4u q = wp[v * 64]; wfp[v >> 2][(v >> 1) & 1][4 * (v & 1)] = q.x; wfp[v >> 2][(v >> 1) & 1][4 * (v & 1) + 1] = q.y; wfp[v >> 2][(v >> 1) & 1][4 * (v & 1) + 2] = q.z; wfp[v >> 2][(v >> 1) & 1][4 * (v & 1) + 3] = q.w; }
    }
    if (!FINAL && !COMBINE) {
#pragma unroll
        for (int j = 0; j < 4; ++j)
#pragma unroll
            for (int p = 0; p < 2; ++p) { const float* p0 = win0 + (size_t)(4 * lane + 256 * j + 2 * p) * INW + SRC_FF; const float* p1 = p0 + INW;
                const f32x4 a0 = *(const GAS f32x4*)p0, b0 = *(const GAS f32x4*)(p0 + 4), a1 = *(const GAS f32x4*)p1, b1 = *(const GAS f32x4*)(p1 + 4);
                wfp[j][p][0] = pk2(a0.x, a1.x); wfp[j][p][1] = pk2(a0.y, a1.y); wfp[j][p][2] = pk2(a0.z, a1.z); wfp[j][p][3] = pk2(a0.w, a1.w);
                wfp[j][p][4] = pk2(b0.x, b1.x); wfp[j][p][5] = pk2(b0.y, b1.y); wfp[j][p][6] = pk2(b0.z, b1.z); wfp[j][p][7] = pk2(b0.w, b1.w); }
    }
    const unsigned char* Y = F.ws + WS_Y;
    const int4* RT = (const int4*)(F.ws + WS_RT);
    f32x4 vA[4], vB[4], vC[4]; v2u xA[4], xB[4], xC[4]; unsigned yaA[4], ybA[4], yaB[4], ybB[4], yaC[4], ybC[4];
    const bf16* XBp = (const bf16*)(F.ws + WS_XB);
#define PA_LOADROW(VN, XN, YA, YB, mm) do { if ((mm) < M) { \
        if (COMBINE) { _Pragma("unroll") for (int j = 0; j < 4; ++j) XN[j] = *(const GAS v2u*)(XBp + (size_t)(mm) * DM + 4 * lane + 256 * j); } \
        else { _Pragma("unroll") for (int j = 0; j < 4; ++j) VN[j] = *(const GAS f32x4*)(xin + (size_t)(mm) * DM + 4 * lane + 256 * j); } \
        if (COMBINE) { const int4 rt_ = RT[mm]; const size_t s0 = (size_t)(256 * aux[AUX_TS + rt_.x] + rt_.y), s1 = (size_t)(256 * aux[AUX_TS + rt_.z] + rt_.w); \
            _Pragma("unroll") for (int j = 0; j < 4; ++j) { YA[j] = *(const GAS unsigned*)(Y + s0 * DM + 4 * lane + 256 * j); YB[j] = *(const GAS unsigned*)(Y + s1 * DM + 4 * lane + 256 * j); } } } } while (0)
#define PA_ROW(VN, XN, YA, YB, m) do { \
        f32x4 v[4]; \
        if (COMBINE) { _Pragma("unroll") for (int j = 0; j < 4; ++j) { const v2u x_ = XN[j]; v[j] = (f32x4){bf2f(x_.x & 0xffffu), bf2f(x_.x >> 16), bf2f(x_.y & 0xffffu), bf2f(x_.y >> 16)}; } } \
        else { _Pragma("unroll") for (int j = 0; j < 4; ++j) v[j] = VN[j]; } \
        if (COMBINE) { \
            _Pragma("unroll") for (int j = 0; j < 4; ++j) { const int a = (int)YA[j], b = (int)YB[j]; \
                const f32x2 a0 = __builtin_amdgcn_cvt_pk_f32_fp8(a, false), a1 = __builtin_amdgcn_cvt_pk_f32_fp8(a, true), b0 = __builtin_amdgcn_cvt_pk_f32_fp8(b, false), b1 = __builtin_amdgcn_cvt_pk_f32_fp8(b, true); \
                v[j].x += (a0.x + b0.x) * W8_INV; v[j].y += (a0.y + b0.y) * W8_INV; v[j].z += (a1.x + b1.x) * W8_INV; v[j].w += (a1.y + b1.y) * W8_INV; } } \
        PA_LOADROW(VN, XN, YA, YB, (m) + 3 * NGW); \
        pa_row<COMBINE, FINAL>(F, v, m, xout, nw, wfp, fb, lane); } while (0)
    PA_LOADROW(vA, xA, yaA, ybA, gw); PA_LOADROW(vB, xB, yaB, ybB, gw + NGW); PA_LOADROW(vC, xC, yaC, ybC, gw + 2 * NGW);
    for (int m = gw; m < M; m += 3 * NGW) {
        PA_ROW(vA, xA, yaA, ybA, m);
        if (m + NGW < M) PA_ROW(vB, xB, yaB, ybB, m + NGW);
        if (m + 2 * NGW < M) PA_ROW(vC, xC, yaC, ybC, m + 2 * NGW);
    }
}

#undef PA_ROW
#undef PA_LOADROW
template <bool SKIP> struct EpiProjT {
    static constexpr bool PERM = true;
    int wave; bf16* O; const float* rot; unsigned* kb;
    __device__ __forceinline__ void operator()(const f32x4 (&acc)[2][2][4][2], const pg8::Unit& u, int) const {
        int t_ = wave * 64 + lane_id(); asm volatile("" : "+v"(t_));
        const int fr = t_ & 15, fq = (t_ >> 4) & 3, wid_ = __builtin_amdgcn_readfirstlane(t_ >> 6), wr = wid_ >> 2, wc = wid_ & 3;
#if defined(MK_EPIPROBE) && MK_EPIPROBE == 2
        if (SKIP) {
#pragma unroll
            for (int ai = 0; ai < 2; ++ai)
#pragma unroll
                for (int bj = 0; bj < 2; ++bj)
#pragma unroll
                    for (int m = 0; m < 4; ++m) asm volatile("" :: "v"(acc[ai][bj][m][0]), "v"(acc[ai][bj][m][1]));
            return; }
#endif
        const int kind = u.pn >> 1;
        const int row0 = u.pm * 256 + wr * 64 + fr, col0 = u.pn * 256 + wc * 32 + 8 * fq;
        const int i0 = 16 * wc + 4 * fq;
        float lg2h[2]; lg2h[0] = ret_lg2(2 * (u.pn & 1)); lg2h[1] = ret_lg2(2 * (u.pn & 1) + 1);
        float kmx[2] = {0.f, 0.f};
        f32x4 T0[8], T1[8];
        if (kind == 3 || kind == 4) {
#pragma unroll
            for (int am = 0; am < 8; ++am) { const int pos = (row0 + (am >> 2) * 128 + (am & 3) * 16) & (SEQ - 1); const float* tp = rot + ((size_t)pos * 64 + i0) * 2; T0[am] = *(const GAS f32x4*)tp; T1[am] = *(const GAS f32x4*)(tp + 4); }
        } else {
#pragma unroll
            for (int am = 0; am < 8; ++am) { T0[am] = (f32x4){1.f, 0.f, 1.f, 0.f}; T1[am] = T0[am]; }
        }
#pragma unroll
        for (int ai = 0; ai < 2; ++ai)
#pragma unroll
            for (int m = 0; m < 4; ++m) { const int row = row0 + ai * 128 + m * 16, pos = row & (SEQ - 1);
                bf16* rowp = O + (size_t)row * NPROJ + col0;
                const f32x4 t0 = T0[ai * 4 + m], t1 = T1[ai * 4 + m];
#pragma unroll
                for (int bj = 0; bj < 2; ++bj) { f32x4 v0 = acc[ai][bj][m][0], v1 = acc[ai][bj][m][1];
                    if (kind == 0) { v0 = v0 * attn_body::C2; v1 = v1 * attn_body::C2; }
                    else if (kind == 3 || kind == 4) {
                        f32x4 w0, w1;
                        w0.x = v0.x * t0.x - v0.y * t0.y; w0.y = v0.x * t0.y + v0.y * t0.x; w0.z = v0.z * t0.z - v0.w * t0.w; w0.w = v0.z * t0.w + v0.w * t0.z;
                        w1.x = v1.x * t1.x - v1.y * t1.y; w1.y = v1.x * t1.y + v1.y * t1.x; w1.z = v1.z * t1.z - v1.w * t1.w; w1.w = v1.z * t1.w + v1.w * t1.z;
                        v0 = w0; v1 = w1;
                        if (kind == 4) { const float sc = 0.08838834764831845f * __builtin_amdgcn_exp2f(lg2h[bj] * (float)(64 - (pos & 63))); v0 = v0 * sc; v1 = v1 * sc; }
                    } else if (kind == 6) {
                        v0.x = silu_f(v0.x); v0.y = silu_f(v0.y); v0.z = silu_f(v0.z); v0.w = silu_f(v0.w); v1.x = silu_f(v1.x); v1.y = silu_f(v1.y); v1.z = silu_f(v1.z); v1.w = silu_f(v1.w);
                    }
                    if (kind == 1) { const float q2 = ((v0.x * v0.x + v0.y * v0.y) + (v0.z * v0.z + v0.w * v0.w)) + ((v1.x * v1.x + v1.y * v1.y) + (v1.z * v1.z + v1.w * v1.w)); kmx[bj] = fmaxf(kmx[bj], q2); }
                    v4u w; w.x = pg8::cvt_pk_bf16(v0[0], v0[1]); w.y = pg8::cvt_pk_bf16(v0[2], v0[3]); w.z = pg8::cvt_pk_bf16(v1[0], v1[1]); w.w = pg8::cvt_pk_bf16(v1[2], v1[3]);
#ifdef MK_EPIPROBE
                    if (SKIP) asm volatile("" :: "v"(w.x), "v"(w.y), "v"(w.z), "v"(w.w)); else
#endif
                    *(GAS v4u*)(rowp + bj * 128) = w; } }
        if (kind == 1) {
#pragma unroll
            for (int bj = 0; bj < 2; ++bj) { float m_ = kmx[bj]; m_ = fmaxf(m_, shx_f(m_, 1)); m_ = fmaxf(m_, shx_f(m_, 2)); m_ = fmaxf(m_, shx_f(m_, 4)); m_ = fmaxf(m_, shx_f(m_, 8));
                if (fr == 0) { const int b_ = u.pm >> 4, h_ = 4 * (u.pn & 1) + 2 * bj + (wc >> 1), c_ = 4 * (wc & 1) + fq;
                    atomicMax(kb + (b_ * FH + h_) * 8 + c_, __float_as_uint(m_ * 1.02f)); } } }
    }
};

typedef EpiProjT<false> EpiProj;
constexpr int RP = 272;
constexpr int RT_TILE = 64 * RP, RT_BUF = 3 * RT_TILE;
constexpr int RL_OUTP = 2 * RT_BUF, RL_OUTP_W = 32 * 80, RL_SSP = RL_OUTP + 8 * RL_OUTP_W;
static_assert(RL_SSP + 2 * 64 * 4 * 4 <= RING_BYTES, "retention LDS map");
__device__ __forceinline__ int crow16(int r, int hi) { return (r & 3) + 8 * (r >> 2) + 4 * hi; }
typedef short v4i16r __attribute__((ext_vector_type(4)));
__device__ __forceinline__ s16x4 rtr(const LAS unsigned char* p) { return __builtin_bit_cast(s16x4, __builtin_amdgcn_ds_read_tr16_b64_v4i16((LAS v4i16r*)p)); }
__device__ __forceinline__ bf16x8 tr_frag(const LAS unsigned char* img, int ra, int rb, int colb, int lane) {
    const int q = (lane & 15) >> 2, cb = (colb + 16 * ((lane >> 4) & 1) + 4 * (lane & 3)) * 2;
    const s16x4 lo = rtr(img + (ra + q) * RP + cb), hi = rtr(img + (rb + q) * RP + cb);
    return (bf16x8){lo[0], lo[1], lo[2], lo[3], hi[0], hi[1], hi[2], hi[3]};
}
__device__ __forceinline__ bf16x8 pack8(const f32x16& x, int b) {
    v4u w; w.x = pg8::cvt_pk_bf16(x[b], x[b + 1]); w.y = pg8::cvt_pk_bf16(x[b + 2], x[b + 3]); w.z = pg8::cvt_pk_bf16(x[b + 4], x[b + 5]); w.w = pg8::cvt_pk_bf16(x[b + 6], x[b + 7]);
    return __builtin_bit_cast(bf16x8, w);
}
__device__ __forceinline__ bf16x8 ld2x64(const LAS unsigned char* p) {
    const v2u a = *(const LAS v2u*)p, b = *(const LAS v2u*)(p + 16); const v4u w = {a.x, a.y, b.x, b.y}; return __builtin_bit_cast(bf16x8, w);
}
#define RBAR() asm volatile("s_waitcnt lgkmcnt(0)\n\ts_barrier" ::: "memory")
__device__ __forceinline__ void ret_passA(Frame& F) {
    const bf16* PROJ = (const bf16*)(F.ws + WS_PROJ); float* SEG = (float*)(F.ws + WS_SEG);
    const int tid = F.tid, lane = F.lane, r32 = lane & 31, hi = lane >> 5, es = F.wave & 3, dh = F.wave >> 2;
    const int sl = tid >> 3, c16 = (tid & 7) * 16;
    for (int u = F.vcu; u < 256; u += F.G) {
        const int b = u >> 5, hr = (u >> 3) & 3, seg = u & 7; const size_t row0 = (size_t)b * SEQ + seg * 512;
        if (seg == 7) continue;
        const float g64 = __builtin_amdgcn_exp2f(ret_lg2(hr) * 64.f);
        f32x16 acc[2]; acc[0] = f32x16{}; acc[1] = f32x16{};
        const bf16* src = PROJ + (row0 + sl) * NPROJ + hr * 128 + c16;
        v4u k0 = *(const GAS v4u*)(src + PRK), k1 = *(const GAS v4u*)(src + PRK + 8), v0 = *(const GAS v4u*)(src + PRV), v1 = *(const GAS v4u*)(src + PRV + 8);
        __syncthreads();
        { LAS unsigned char* d = F.lds + RT_TILE + sl * RP + c16 * 2; *(LAS v4u*)d = k0; *(LAS v4u*)(d + 16) = k1; *(LAS v4u*)(d + RT_TILE) = v0; *(LAS v4u*)(d + RT_TILE + 16) = v1; }
        src += (size_t)64 * NPROJ;
        k0 = *(const GAS v4u*)(src + PRK); k1 = *(const GAS v4u*)(src + PRK + 8); v0 = *(const GAS v4u*)(src + PRV); v1 = *(const GAS v4u*)(src + PRV + 8);
        RBAR();
        for (int ch = 0; ch < 8; ++ch) {
            int hi_ = hi, lane_ = lane; asm volatile("" : "+v"(hi_), "+v"(lane_));
            const LAS unsigned char* kI = F.lds + (ch & 1) * RT_BUF + RT_TILE; const LAS unsigned char* vI = kI + RT_TILE;
            if (ch > 0) { acc[0] = acc[0] * g64; acc[1] = acc[1] * g64; }
#pragma unroll
            for (int ks = 0; ks < 4; ++ks) { const bf16x8 bv = tr_frag(vI, 16 * ks + 8 * hi_, 16 * ks + 8 * hi_ + 4, 32 * es, lane_);
#pragma unroll
                for (int dt = 0; dt < 2; ++dt) { const bf16x8 av = tr_frag(kI, 16 * ks + 8 * hi_, 16 * ks + 8 * hi_ + 4, 64 * dh + 32 * dt, lane_);
                    acc[dt] = __builtin_amdgcn_mfma_f32_32x32x16_bf16(av, bv, acc[dt], 0, 0, 0); } }
            if (ch + 1 < 8) { LAS unsigned char* d = F.lds + ((ch + 1) & 1) * RT_BUF + RT_TILE + sl * RP + c16 * 2; *(LAS v4u*)d = k0; *(LAS v4u*)(d + 16) = k1; *(LAS v4u*)(d + RT_TILE) = v0; *(LAS v4u*)(d + RT_TILE + 16) = v1; }
            if (ch + 2 < 8) { src += (size_t)64 * NPROJ; k0 = *(const GAS v4u*)(src + PRK); k1 = *(const GAS v4u*)(src + PRK + 8); v0 = *(const GAS v4u*)(src + PRV); v1 = *(const GAS v4u*)(src + PRV + 8); }
            RBAR();
        }
        float* so = SEG + (size_t)u * 128 * 128;
#pragma unroll
        for (int dt = 0; dt < 2; ++dt)
#pragma unroll
            for (int r = 0; r < 16; ++r) { float* sp_ = so + (64 * dh + 32 * dt + crow16(r, hi)) * 128 + 32 * es + r32; if (MK_CHAIN4) __hip_atomic_store((GAS float*)sp_, acc[dt][r], RLX_AGENT); else *sp_ = acc[dt][r]; }
    }
    __syncthreads();
}
constexpr int RB_Q = 0, RB_V = RT_TILE, RB_K = 2 * RT_TILE, RB_SF = 4 * RT_TILE, RB_P = RB_SF + 32768, RB_PP = 144, RB_PATCH = RB_P + 2 * 32 * RB_PP, RB_SSP = RB_PATCH + 8 * RL_OUTP_W;
static_assert((AUX_U2 + 64) * 4 <= AUX_BYTES && AUX_TOK + AUX_MAXU * 256 <= AUX_U2, "AUX map");
static_assert(RB_SSP + 64 * 4 * 4 <= MISC_OFF, "retention pass B LDS map");
__device__ __forceinline__ void ret_passB_unit(Frame& F, const int u) {
    const bf16* PROJ = (const bf16*)(F.ws + WS_PROJ); const float* SEG = (const float*)(F.ws + WS_SEG); bf16* MIX = (bf16*)(F.ws + WS_HN);
    const int tid = F.tid, lane = F.lane, r32 = lane & 31, hi = lane >> 5, es = F.wave & 3, qh = F.wave >> 2;
    const int sl = tid >> 3, c16 = (tid & 7) * 16, jc = lane & 15, g4 = lane >> 4;
    LAS unsigned char* const qI = F.lds + RB_Q; LAS unsigned char* const vI = F.lds + RB_V; LAS unsigned char* const sfI = F.lds + RB_SF + es * 8192; LAS unsigned char* const pI = F.lds + RB_P + qh * (32 * RB_PP);
    LAS float* const ssp = (LAS float*)(F.lds + RB_SSP);
    const int b = u >> 5, hr = (u >> 3) & 3, seg = u & 7; const size_t row0 = (size_t)b * SEQ + seg * 512;
    const float lg2 = ret_lg2(hr), g64 = __builtin_amdgcn_exp2f(lg2 * 64.f), g512 = __builtin_amdgcn_exp2f(lg2 * 512.f);
    const bf16* src = PROJ + (row0 + sl) * NPROJ + hr * 128 + c16;
    v4u q0 = *(const GAS v4u*)(src + PRQ), q1 = *(const GAS v4u*)(src + PRQ + 8), k0 = *(const GAS v4u*)(src + PRK), k1 = *(const GAS v4u*)(src + PRK + 8),
        v0 = *(const GAS v4u*)(src + PRV), v1 = *(const GAS v4u*)(src + PRV + 8);
    f32x16 S0 = f32x16{}, S1 = f32x16{};
    for (int g = 0; g < seg; ++g) { const float* sp = SEG + (size_t)(u - seg + g) * 128 * 128 + (size_t)(64 * qh) * 128 + 32 * es + r32;
#pragma unroll
        for (int r = 0; r < 16; ++r) { S0[r] = S0[r] * g512 + sp[crow16(r, hi) * 128]; S1[r] = S1[r] * g512 + sp[(32 + crow16(r, hi)) * 128]; } }
    const float gj = __builtin_amdgcn_exp2f(lg2 * (float)(32 * qh + r32));
    const int l0 = 16 * es + 4 * g4; int jj[2]; float fa[2], fb[2];
#pragma unroll
    for (int jt = 0; jt < 2; ++jt) { jj[jt] = 32 * qh + 16 * jt + jc; fa[jt] = __builtin_amdgcn_exp2f(lg2 * (float)(jj[jt] - 64)); fb[jt] = __builtin_amdgcn_exp2f(lg2 * (float)(2 * l0 - jj[jt] - 64)); }
    float gr[4]; gr[0] = 1.f; gr[1] = __builtin_amdgcn_exp2f(lg2 * 2.f); gr[2] = gr[1] * gr[1]; gr[3] = gr[2] * gr[1];
    const int cbl = (16 * ((lane >> 4) & 1) + 4 * (lane & 3)) * 2, tq = (lane & 15) >> 2;
    const int oTN = (8 * hi + tq) * RP + cbl;
    const int oQ2 = (32 * qh + r32) * RP + 8 * hi;
    const int oKs = (16 * es + jc) * RP + 16 * g4, oQs = (32 * qh + jc) * RP + 16 * g4;
#define TRF(img, off, rowa, rowb, colb) ({ const s16x4 lo_ = rtr((img) + (off) + (rowa) * RP + (colb) * 2), hi_v = rtr((img) + (off) + (rowb) * RP + (colb) * 2); \
        (bf16x8){lo_[0], lo_[1], lo_[2], lo_[3], hi_v[0], hi_v[1], hi_v[2], hi_v[3]}; })
#define ST16(img, a_, b_) do { LAS unsigned char* d_ = (img) + sl * RP + c16 * 2; *(LAS v4u*)d_ = (a_); *(LAS v4u*)(d_ + 16) = (b_); } while (0)
#define SF_WRITE() do { *(LAS v4u*)(sfI + ((4 * qh + 0) * 64 + lane) * 16) = __builtin_bit_cast(v4u, pack8(S0, 0)); *(LAS v4u*)(sfI + ((4 * qh + 1) * 64 + lane) * 16) = __builtin_bit_cast(v4u, pack8(S0, 8)); \
        *(LAS v4u*)(sfI + ((4 * qh + 2) * 64 + lane) * 16) = __builtin_bit_cast(v4u, pack8(S1, 0)); *(LAS v4u*)(sfI + ((4 * qh + 3) * 64 + lane) * 16) = __builtin_bit_cast(v4u, pack8(S1, 8)); } while (0)
    __syncthreads();
    ST16(qI, q0, q1); ST16(F.lds + RB_K, k0, k1); SF_WRITE();
    f32x16 o = f32x16{}; v2u gt[4]; gt[0] = (v2u){0u, 0u}; gt[1] = gt[0]; gt[2] = gt[0]; gt[3] = gt[0]; size_t orow = 0; const int ocol = hr * 128 + 32 * es;
    for (int ch = 0; ch <= 8; ++ch) {
        RBAR();
        if (ch > 0) {
            const f32x4 p4 = *(const LAS f32x4*)(ssp + (32 * qh + r32) * 4);
            const float rstd = __builtin_amdgcn_rsqf(((p4.x + p4.y) + (p4.z + p4.w)) * (1.f / 128.f) + eps_s()) * MIX_SCALE;
#if MK_MIX8
            unsigned w8[4];
#pragma unroll
            for (int g = 0; g < 4; ++g) { const v2u gv = gt[g];
                w8[g] = pg8::pk4_fp8(o[4 * g] * rstd * bf2f(gv.x & 0xffffu), o[4 * g + 1] * rstd * bf2f(gv.x >> 16), o[4 * g + 2] * rstd * bf2f(gv.y & 0xffffu), o[4 * g + 3] * rstd * bf2f(gv.y >> 16)); }
            { auto r0 = __builtin_amdgcn_permlane32_swap(w8[0], w8[2], false, false); w8[0] = r0[0]; w8[2] = r0[1];
              auto r1 = __builtin_amdgcn_permlane32_swap(w8[1], w8[3], false, false); w8[1] = r1[0]; w8[3] = r1[1]; }
            *(GAS v4u*)((unsigned char*)MIX + orow * DM + 512 + ocol + 16 * hi) = (v4u){w8[0], w8[2], w8[1], w8[3]};
#else
            v2u w[4];
#pragma unroll
            for (int g = 0; g < 4; ++g) { const v2u gv = gt[g];
                w[g].x = pg8::cvt_pk_bf16(o[4 * g] * rstd * bf2f(gv.x & 0xffffu), o[4 * g + 1] * rstd * bf2f(gv.x >> 16));
                w[g].y = pg8::cvt_pk_bf16(o[4 * g + 2] * rstd * bf2f(gv.y & 0xffffu), o[4 * g + 3] * rstd * bf2f(gv.y >> 16)); }
            { auto r0 = __builtin_amdgcn_permlane32_swap(w[0].x, w[2].x, false, false); w[0].x = r0[0]; w[2].x = r0[1];
              auto r1 = __builtin_amdgcn_permlane32_swap(w[0].y, w[2].y, false, false); w[0].y = r1[0]; w[2].y = r1[1];
              auto r2 = __builtin_amdgcn_permlane32_swap(w[1].x, w[3].x, false, false); w[1].x = r2[0]; w[3].x = r2[1];
              auto r3 = __builtin_amdgcn_permlane32_swap(w[1].y, w[3].y, false, false); w[1].y = r3[0]; w[3].y = r3[1]; }
            bf16* op = MIX + orow * DM + 512 + ocol + 16 * hi;
            *(GAS v4u*)op = (v4u){w[0].x, w[0].y, w[2].x, w[2].y};
            *(GAS v4u*)(op + 8) = (v4u){w[1].x, w[1].y, w[3].x, w[3].y};
#endif
        }
        if (ch == 8) break;
        const LAS unsigned char* kI = F.lds + RB_K + (ch & 1) * RT_TILE;
        ST16(vI, v0, v1);
        if (ch + 1 < 8) { src += (size_t)64 * NPROJ; q0 = *(const GAS v4u*)(src + PRQ); q1 = *(const GAS v4u*)(src + PRQ + 8); k0 = *(const GAS v4u*)(src + PRK); k1 = *(const GAS v4u*)(src + PRK + 8);
            v0 = *(const GAS v4u*)(src + PRV); v1 = *(const GAS v4u*)(src + PRV + 8); }
        orow = row0 + 64 * ch + 32 * qh + r32;
#pragma unroll
        for (int g = 0; g < 4; ++g) gt[g] = *(const GAS v2u*)(PROJ + orow * NPROJ + PRG + ocol + 8 * g + 4 * hi);
        {
            f32x4 sc[2]; sc[0] = (f32x4){0.f, 0.f, 0.f, 0.f}; sc[1] = sc[0];
#pragma unroll
            for (int ks = 0; ks < 4; ++ks) { const bf16x8 kf = *(const LAS bf16x8*)(kI + oKs + 64 * ks);
#pragma unroll
                for (int jt = 0; jt < 2; ++jt) { const bf16x8 qf = *(const LAS bf16x8*)(qI + oQs + 16 * jt * RP + 64 * ks);
                    sc[jt] = __builtin_amdgcn_mfma_f32_16x16x32_bf16(kf, qf, sc[jt], 0, 0, 0); } }
#pragma unroll
            for (int jt = 0; jt < 2; ++jt) { float w_[4];
#pragma unroll
                for (int r = 0; r < 4; ++r) w_[r] = sc[jt][r] * ((l0 + r <= jj[jt]) ? fa[jt] : fb[jt] * gr[r]);
                *(LAS v2u*)(pI + (16 * jt + jc) * RB_PP + l0 * 2) = (v2u){pg8::cvt_pk_bf16(w_[0], w_[1]), pg8::cvt_pk_bf16(w_[2], w_[3])}; }
        }
        o = f32x16{};
#pragma unroll
        for (int dt = 0; dt < 4; ++dt)
#pragma unroll
            for (int s2 = 0; s2 < 2; ++s2) { const bf16x8 qf = ld2x64(qI + oQ2 + (32 * dt + 16 * s2) * 2); const bf16x8 sf = *(const LAS bf16x8*)(sfI + ((2 * dt + s2) * 64 + lane) * 16);
                o = __builtin_amdgcn_mfma_f32_32x32x16_bf16(sf, qf, o, 0, 0, 0); }
#pragma unroll
        for (int r = 0; r < 16; ++r) o[r] *= gj;
        RBAR();
#pragma unroll
        for (int ks = 0; ks < 4; ++ks) { const bf16x8 pf = *(const LAS bf16x8*)(pI + r32 * RB_PP + 32 * ks + 16 * hi); const bf16x8 vf = TRF(vI, oTN, 16 * ks, 16 * ks + 4, 32 * es);
            o = __builtin_amdgcn_mfma_f32_32x32x16_bf16(vf, pf, o, 0, 0, 0); }
        { float t = 0.f;
#pragma unroll
          for (int r = 0; r < 16; ++r) t += o[r] * o[r];
          const auto sw = __builtin_amdgcn_permlane32_swap(__float_as_uint(t), __float_as_uint(t), false, false);
          if (hi == 0) ssp[(32 * qh + r32) * 4 + es] = __uint_as_float(sw[0]) + __uint_as_float(sw[1]); }
        S0 = S0 * g64; S1 = S1 * g64;
#pragma unroll
        for (int ks = 0; ks < 4; ++ks) { const bf16x8 bv = TRF(vI, oTN, 16 * ks, 16 * ks + 4, 32 * es);
            const bf16x8 a0 = TRF(kI, oTN, 16 * ks, 16 * ks + 4, 64 * qh), a1 = TRF(kI, oTN, 16 * ks, 16 * ks + 4, 64 * qh + 32);
            S0 = __builtin_amdgcn_mfma_f32_32x32x16_bf16(a0, bv, S0, 0, 0, 0); S1 = __builtin_amdgcn_mfma_f32_32x32x16_bf16(a1, bv, S1, 0, 0, 0); }
        SF_WRITE();
        if (ch + 1 < 8) { ST16(qI, q0, q1); ST16(F.lds + RB_K + ((ch + 1) & 1) * RT_TILE, k0, k1); }
    }
#undef TRF
#undef ST16
#undef SF_WRITE
    __syncthreads();
}
#undef RBAR
static_assert(IT_DENSE % CVT_UNITS == 0, "dense items per conversion unit");
__device__ __forceinline__ void pc_phase(Frame& F, int layer, int qsel, const float* w_in, const float* w_out, const float* w_eg, const float* w_eu, const float* w_ed) {
    const bf16* P = (const bf16*)(F.ws + WS_PROJ); const float* CL = (const float*)(F.ws + WS_CL);
    const unsigned* KBw = (const unsigned*)(F.ctl + CW_KB + layer * 512);
    LAS int* qslot = (LAS int*)(F.lds + attn_body::LDS_CLTMP + 64);
    bool pc0_ok = false;
    for (;;) {
        __syncthreads();
        if (F.tid == 0) *qslot = (int)__hip_atomic_fetch_add(F.ctl + CW_Q + qsel, 1u, RLX_AGENT);
        __syncthreads();
        const int qidx = __builtin_amdgcn_readfirstlane(*qslot);
        if (qidx >= CVT_UNITS + 1024 + 256) break;
#ifdef MK_PCPROBE
        if (qsel >= 2) { const int cat = qidx < CVT_UNITS ? 1 : qidx < 256 + CVT_UNITS ? 4 : 2; if (!((MK_PCPROBE) & cat)) continue; }
#endif
        if (MK_CHAIN4 && !MK_MULTI && qidx >= CVT_UNITS && !pc0_ok) {
            if (F.wave == 0) { unsigned sp = 0u; unsigned* tmo = (unsigned*)(F.ctl + CW_BAR + XB_TMO); const unsigned need_ = (unsigned)F.G * NWAVES;
                while ((unsigned)__builtin_amdgcn_readfirstlane(__hip_atomic_load(F.ctl + CW_PC0 + layer, RLX_AGENT)) < need_) {
                    if ((++sp & 255u) == 0u) { if (__builtin_amdgcn_readfirstlane(__hip_atomic_load(tmo, RLX_AGENT)) != 0u) break; if (sp > (1u << 18)) { if (lane_id() == 0) __hip_atomic_store(tmo, 1u, RLX_AGENT); break; } } }
                __builtin_amdgcn_fence(__ATOMIC_ACQUIRE, "agent");
                asm volatile("s_waitcnt vmcnt(0)" ::: "memory"); }
            __syncthreads(); pc0_ok = true; }
        if (qidx >= CVT_UNITS && qidx < CVT_UNITS + 256) { const int rq = qidx - CVT_UNITS;
            { int t_ = F.wave * 64 + lane_id(); asm volatile("" : "+v"(t_)); F.tid = t_; F.lane = t_ & 63; }
            ret_passB_unit(F, (rq & 31) * 8 + 7 - (rq >> 5));
            continue;
        }
        if (qidx < CVT_UNITS) {
            { int t_ = F.wave * 64 + lane_id(); asm volatile("" : "+v"(t_)); F.tid = t_; F.lane = t_ & 63; }
            LAS float* scr = (LAS float*)(F.lds) + F.wave * (64 * 65);
            for (int j = F.wave; j < CVT_PER_UNIT; j += NWAVES) p0_do_item(F, layer, IT_DENSE + qidx * CVT_PER_UNIT + j, nullptr, nullptr, w_eg, w_eu, w_ed, scr);
            if (layer + 1 < DEPTH) for (int j = F.wave; j < IT_DENSE / CVT_UNITS; j += NWAVES) p0_do_item(F, layer + 1, qidx * (IT_DENSE / CVT_UNITS) + j, w_in, w_out, nullptr, nullptr, nullptr, scr);
            continue;
        }
        const int idx = qidx - 256 - CVT_UNITS;
        {
            const int qb = 15 - (idx >> 6), bh = idx & 63;
            LAS f32x4* cl4 = (LAS f32x4*)(F.lds + attn_body::LDS_CL); const f32x4* src4 = (const f32x4*)(CL + (size_t)bh * SEQ);
            for (int i = F.tid; i < (qb + 1) * 64; i += NTHREADS) cl4[i] = src4[i];
            float kb2 = 0.f;
#pragma unroll
            for (int c = 0; c < 8; ++c) kb2 += __uint_as_float(KBw[bh * 8 + c]);
            const float Kb = __builtin_amdgcn_sqrtf(kb2) * 1.0001f;
            __syncthreads();
            attn_body::attn_unit<8>(bh >> 3, bh & 7, qb, (const attn_body::hb16*)(P + PQ), (const attn_body::hb16*)(P + PK), (const attn_body::hb16*)(P + PV), (attn_body::hb16*)(F.ws + WS_HN), (char*)F.lds, Kb, F.wave);
        }
    }
}
__device__ __forceinline__ void cl_tables(Frame& F) {
    const bool paired = (F.G == 256);
    const int first = paired ? (((F.vcu & 7) == 7) ? 2 * (F.vcu >> 3) : 64) : F.vcu, n = paired ? 2 : 1;
    for (int t = 0; t < n; ++t) { const int bh = first + t;
        if (bh < 64) {
            attn_body::fox_cumsum((const float*)(F.ws + WS_LOGF), bh >> 3, bh & 7, (char*)F.lds, F.wave);
            const LAS f32x4* cl4 = (const LAS f32x4*)(F.lds + attn_body::LDS_CL); f32x4* dst4 = (f32x4*)((float*)(F.ws + WS_CL) + (size_t)bh * SEQ);
            for (int i = F.tid; i < SEQ / 4; i += NTHREADS) { const f32x4 c_ = cl4[i]; if (MK_CHAIN4) { ST_WT8(dst4 + i, __float_as_uint(c_.x), __float_as_uint(c_.y)); ST_WT8((float*)(dst4 + i) + 2, __float_as_uint(c_.z), __float_as_uint(c_.w)); } else dst4[i] = c_; }
            __syncthreads();
        } }
}

struct EpiRes {
    static constexpr bool PERM = true;
    int wave; const float* basef; bf16* xb; float* rowss;
    __device__ __forceinline__ void operator()(const f32x4 (&acc)[2][2][4][2], const pg8::Unit& u, int) const {
        int t_ = wave * 64 + lane_id(); asm volatile("" : "+v"(t_));
        const int fr = t_ & 15, fq = (t_ >> 4) & 3, wid_ = __builtin_amdgcn_readfirstlane(t_ >> 6), wr = wid_ >> 2, wc = wid_ & 3;
        const int col0 = u.pn * 256 + wc * 32 + 8 * fq;
        const bool f32base = basef != nullptr;
        const float ws_ = MK_MIX8 ? W8_INV / MIX_SCALE : 1.f;
#pragma unroll
        for (int ai = 0; ai < 2; ++ai) {
            const size_t off0 = (size_t)(u.pm * 256 + ai * 128 + wr * 64 + fr) * DM + col0;
            f32x4 b[4][2][2];
            if (f32base) {
#pragma unroll
                for (int m = 0; m < 4; ++m)
#pragma unroll
                    for (int bj = 0; bj < 2; ++bj) { const float* p = basef + off0 + (size_t)m * 16 * DM + bj * 128; b[m][bj][0] = *(const GAS f32x4*)p; b[m][bj][1] = *(const GAS f32x4*)(p + 4); }
            } else {
                v4u q[4][2];
#pragma unroll
                for (int m = 0; m < 4; ++m)
#pragma unroll
                    for (int bj = 0; bj < 2; ++bj) q[m][bj] = *(const GAS v4u*)(xb + off0 + (size_t)m * 16 * DM + bj * 128);
#pragma unroll
                for (int m = 0; m < 4; ++m)
#pragma unroll
                    for (int bj = 0; bj < 2; ++bj) { const v4u w = q[m][bj];
                        b[m][bj][0] = (f32x4){bf2f(w.x & 0xffffu), bf2f(w.x >> 16), bf2f(w.y & 0xffffu), bf2f(w.y >> 16)}; b[m][bj][1] = (f32x4){bf2f(w.z & 0xffffu), bf2f(w.z >> 16), bf2f(w.w & 0xffffu), bf2f(w.w >> 16)}; }
            }
#pragma unroll
            for (int m = 0; m < 4; ++m) { const int r = u.pm * 256 + ai * 128 + wr * 64 + m * 16 + fr; float ss = 0.f;
#pragma unroll
                for (int bj = 0; bj < 2; ++bj) {
                    const f32x4 o0 = b[m][bj][0] + acc[ai][bj][m][0] * ws_, o1 = b[m][bj][1] + acc[ai][bj][m][1] * ws_;
                    *(GAS v4u*)(xb + off0 + (size_t)m * 16 * DM + bj * 128) = (v4u){pg8::cvt_pk_bf16(o0.x, o0.y), pg8::cvt_pk_bf16(o0.z, o0.w), pg8::cvt_pk_bf16(o1.x, o1.y), pg8::cvt_pk_bf16(o1.z, o1.w)};
                    ss += ((o0.x * o0.x + o0.y * o0.y) + (o0.z * o0.z + o0.w * o0.w)) + ((o1.x * o1.x + o1.y * o1.y) + (o1.z * o1.z + o1.w * o1.w)); }
                ss += shx_f(ss, 16); ss += shx_f(ss, 32);
                if (fq == 0) rowss[(size_t)r * 16 + u.pn * 4 + wc] = ss; }
            asm volatile("" ::: "memory");
        }
    }
};

constexpr int PF_FR = 0, PF_LG = 98304, PF_NW = 122880, PF_HIST = 126976, PF_BASE = 127104;
__device__ __forceinline__ void pf_phase(Frame& F, int layer, const float* brg, const float* bre, const float* normw) {
    const int tid = F.tid, lane = F.lane, wave = F.wave;
    const float* rowss = (const float*)(F.ws + WS_ROWSS);
    LAS v4u* fr = (LAS v4u*)(F.lds + PF_FR); LAS float* lg = (LAS float*)(F.lds + PF_LG) + wave * (16 * 48); LAS float* nwl = (LAS float*)(F.lds + PF_NW);
    LAS int* hist = (LAS int*)(F.lds + PF_HIST); LAS int* basel = (LAS int*)(F.lds + PF_BASE);
    { const v4u* rfr = (const v4u*)(F.ws + WS_RFR) + (size_t)layer * RFR_N;
      for (int q = tid; q < RFR_N; q += NTHREADS) fr[q] = rfr[q]; }
    for (int q = tid; q < DM; q += NTHREADS) nwl[q] = normw[q];
    if (tid < 32) hist[tid] = 0;
    __syncthreads();
    unsigned char* HN8 = F.ws + WS_HN; int4* RT = (int4*)(F.ws + WS_RT); int* TOK = (int*)(F.ws + WS_TOK); float* WL = (float*)(F.ws + WS_WL);
    const int NRG = M / 16, per = F.G * NWAVES, iters = (NRG + per - 1) / per;
    for (int it = 0; it < iters; ++it) {
        const int rg = it * per + F.vcu * NWAVES + wave; const bool valid = rg < NRG;
        int e1 = 0, e2 = 0, lr1 = 0, lr2 = 0; float w1 = 0.f, w2 = 0.f;
        if (valid) {
            const int row = rg * 16 + (lane & 15), g = lane >> 4;
            float ss = 0.f;
#pragma unroll
            for (int j = 0; j < 4; ++j) { const f32x4 p = *(const GAS f32x4*)(rowss + (size_t)row * 16 + 4 * j); ss += (p.x + p.y) + (p.z + p.w); }
            const float rstd = __builtin_amdgcn_rsqf(ss * (1.f / DM) + eps_s());
            f32x4 acc[3]; acc[0] = (f32x4){0.f, 0.f, 0.f, 0.f}; acc[1] = acc[0]; acc[2] = acc[0];
            const bf16* xr = (const bf16*)(F.ws + WS_XB) + (size_t)row * DM + 8 * g; unsigned char* hr = HN8 + ((size_t)row * DM + 8 * g) * XSZ;
            v4u xqa[32];
#pragma unroll
            for (int s = 0; s < 32; ++s) xqa[s] = *(const GAS v4u*)(xr + 32 * s);
#pragma unroll
            for (int s = 0; s < 32; ++s) {
                const v4u xq = xqa[s];
                const f32x4 xa = {bf2f(xq.x & 0xffffu), bf2f(xq.x >> 16), bf2f(xq.y & 0xffffu), bf2f(xq.y >> 16)}, xb = {bf2f(xq.z & 0xffffu), bf2f(xq.z >> 16), bf2f(xq.w & 0xffffu), bf2f(xq.w >> 16)};
                const f32x4 na = *(const LAS f32x4*)(nwl + 32 * s + 8 * g), nb = *(const LAS f32x4*)(nwl + 32 * s + 8 * g + 4);
                const f32x4 ha = xa * rstd * na, hb = xb * rstd * nb;
                const v4u hw = {pk2(ha.x, ha.y), pk2(ha.z, ha.w), pk2(hb.x, hb.y), pk2(hb.z, hb.w)};
                if (MK_FP8) *(GAS v2u*)(hr + 32 * s) = (v2u){pg8::pk4_fp8(ha.x, ha.y, ha.z, ha.w), pg8::pk4_fp8(hb.x, hb.y, hb.z, hb.w)};
                else *(GAS v4u*)(hr + 64 * s) = hw;
                const bf16x8 af = __builtin_bit_cast(bf16x8, hw);
#pragma unroll
                for (int nt = 0; nt < 3; ++nt) { const bf16x8 bf = __builtin_bit_cast(bf16x8, fr[(s * 3 + nt) * 64 + lane]);
                    acc[nt] = __builtin_amdgcn_mfma_f32_16x16x32_bf16(af, bf, acc[nt], 0, 0, 0); }
            }
#pragma unroll
            for (int nt = 0; nt < 3; ++nt)
#pragma unroll
                for (int r = 0; r < 4; ++r) lg[(4 * g + r) * 48 + 16 * nt + (lane & 15)] = acc[nt][r];
            LDS_WAIT(); asm volatile("" ::: "memory");
            if (lane < 16) {
                const LAS float* L = lg + lane * 48;
                float gl[4]; int gi = 0;
#pragma unroll
                for (int j = 0; j < 4; ++j) gl[j] = L[j] + brg[j];
#pragma unroll
                for (int j = 1; j < 4; ++j) if (gl[j] > gl[gi]) gi = j;
                float gs = 0.f;
#pragma unroll
                for (int j = 0; j < 4; ++j) gs += __expf(gl[j] - gl[gi]);
                const float gw_ = 1.f / gs;
                float el[8];
#pragma unroll
                for (int j = 0; j < 8; ++j) el[j] = L[NG + 8 * gi + j] + bre[8 * gi + j];
                int i1 = 0;
#pragma unroll
                for (int j = 1; j < 8; ++j) if (el[j] > el[i1]) i1 = j;
                int i2 = -1;
#pragma unroll
                for (int j = 0; j < 8; ++j) if (j != i1 && (i2 < 0 || el[j] > el[i2])) i2 = j;
                const float p1 = 1.f / (1.f + __expf(el[i2] - el[i1]));
                w1 = gw_ * p1; w2 = gw_ * (1.f - p1);
                e1 = 8 * gi + i1; e2 = 8 * gi + i2;
                lr1 = atomicAdd((int*)(hist + e1), 1); lr2 = atomicAdd((int*)(hist + e2), 1);
            }
        }
        __syncthreads();
        if (tid < 32) { const int c = hist[tid]; basel[tid] = c ? (int)__hip_atomic_fetch_add(F.ctl + CW_CNT + layer * 32 + tid, (unsigned)c, RLX_AGENT) : 0; hist[tid] = 0; }
        __syncthreads();
        if (valid && lane < 16) { const int row = rg * 16 + lane; const int r1 = basel[e1] + lr1, r2 = basel[e2] + lr2;
            RT[row] = make_int4(e1, r1, e2, r2);
            TOK[(size_t)e1 * CAP + r1] = row; WL[(size_t)e1 * CAP + r1] = w1; TOK[(size_t)e2 * CAP + r2] = row; WL[(size_t)e2 * CAP + r2] = w2; }
        __syncthreads();
    }
}

struct ExpertOrder1 {
    static constexpr bool GATHER = true;
    const char* A; const char* Bt; LAS int* aux; int G, vcu;
    __device__ __forceinline__ bool next(int i, pg8::Unit& u) const {
        if (i >= 16) return false;
        const int e = __builtin_amdgcn_readfirstlane(aux[AUX_U + 2 * i]); if (e < 0) return false;
        const int L = i * G + vcu; u.pm = L >> 2; u.pn = L & 3; u.e = e; u.ml = __builtin_amdgcn_readfirstlane(aux[AUX_U + 2 * i + 1]); return true; }
    __device__ __forceinline__ const char* a_base(const pg8::Unit&) const { return A; }
    __device__ __forceinline__ const char* b_base(const pg8::Unit& u) const { return Bt + ((size_t)u.e * 1024 + u.pn * 256) * 1024 * XSZ; }
    __device__ __forceinline__ unsigned a_row_off(int ui, int r) const { return (unsigned)aux[AUX_TOK + ui * 256 + r] * (unsigned)(DM * XSZ); }
    __device__ __forceinline__ void a_ready(const pg8::Unit&, int) const {}
};
struct ExpertOrder2 {
    static constexpr bool GATHER = false;
    const char* A; const char* Bt; LAS int* aux; int G, vcu; const unsigned* rdy; unsigned* tmo;
    __device__ __forceinline__ bool next(int i, pg8::Unit& u) const {
        if (i >= 16) return false;
        const int e = __builtin_amdgcn_readfirstlane(aux[AUX_U2 + 4 * i]); if (e < 0) return false;
        u.e = e; u.ml = __builtin_amdgcn_readfirstlane(aux[AUX_U2 + 4 * i + 1]); u.pm = __builtin_amdgcn_readfirstlane(aux[AUX_U2 + 4 * i + 2]); u.pn = __builtin_amdgcn_readfirstlane(aux[AUX_U2 + 4 * i + 3]); return true; }
    __device__ __forceinline__ const char* a_base(const pg8::Unit& u) const { return A + (size_t)u.pm * 256 * DE * XSZ; }
    __device__ __forceinline__ const char* b_base(const pg8::Unit& u) const { return Bt + ((size_t)u.e * 1024 + u.pn * 256) * DE * XSZ; }
    __device__ __forceinline__ unsigned a_row_off(int, int) const { return 0u; }
    __device__ __forceinline__ void a_ready(const pg8::Unit& u, int wave_) const {
        if (MK_CHAIN) {
            if (wave_ == 0) { unsigned sp = 0u;
                while ((unsigned)__builtin_amdgcn_readfirstlane(__hip_atomic_load(rdy + 64 * u.pm, RLX_AGENT)) < 32u) {
                    if ((++sp & 255u) == 0u) { if (__builtin_amdgcn_readfirstlane(__hip_atomic_load(tmo, RLX_AGENT)) != 0u) break; if (sp > (1u << 18)) { if (lane_id() == 0) __hip_atomic_store(tmo, 1u, RLX_AGENT); break; } } }
#ifndef MK_CHAIN_ACQ
#define MK_CHAIN_ACQ 1
#endif
                if (MK_CHAIN_ACQ) { __builtin_amdgcn_fence(__ATOMIC_ACQUIRE, "agent");
                    asm volatile("s_waitcnt vmcnt(0)" ::: "memory"); } }
            asm volatile("" ::: "memory"); __builtin_amdgcn_s_barrier(); asm volatile("" ::: "memory");
        }
    }
};
struct EpiSwiGLU {
    static constexpr bool PERM = true;
    int wave; unsigned char* A1; unsigned* rdy;
    __device__ __forceinline__ void operator()(const f32x4 (&acc)[2][2][4][2], const pg8::Unit& u, int) const {
        int t_ = wave * 64 + lane_id(); asm volatile("" : "+v"(t_));
        const int fr = t_ & 15, fq = (t_ >> 4) & 3, wid_ = __builtin_amdgcn_readfirstlane(t_ >> 6), wr = wid_ >> 2, wc = wid_ & 3;
#pragma unroll
        for (int ai = 0; ai < 2; ++ai)
#pragma unroll
            for (int m = 0; m < 4; ++m) { const size_t slot = (size_t)u.pm * 256 + ai * 128 + wr * 64 + m * 16 + fr;
                const float ws_ = W8_INV;
                const f32x4 g0 = acc[ai][0][m][0] * ws_, g1 = acc[ai][0][m][1] * ws_, u0 = acc[ai][1][m][0] * ws_, u1 = acc[ai][1][m][1] * ws_;
                v2u w; w.x = pg8::pk4_fp8(silu_f(g0.x) * u0.x, silu_f(g0.y) * u0.y, silu_f(g0.z) * u0.z, silu_f(g0.w) * u0.w);
                w.y = pg8::pk4_fp8(silu_f(g1.x) * u1.x, silu_f(g1.y) * u1.y, silu_f(g1.z) * u1.z, silu_f(g1.w) * u1.w);
                unsigned char* dp = A1 + slot * DE + u.pn * 128 + wc * 32 + 8 * fq;
                if (MK_CHAIN) __hip_atomic_store((GAS unsigned long long*)dp, ((unsigned long long)w.y << 32) | (unsigned long long)w.x, RLX_AGENT);
                else *(GAS v2u*)dp = w; }
        if (MK_CHAIN) {
            asm volatile("s_waitcnt vmcnt(0)" ::: "memory");
            if (lane_id() == 0) (void)__hip_atomic_fetch_add(rdy + 64 * u.pm, 1u, RLX_AGENT);
        }
    }
};
struct EpiDown {
    static constexpr bool PERM = true;
    int wave; unsigned char* ws; LAS int* aux;
    __device__ __forceinline__ void operator()(const f32x4 (&acc)[2][2][4][2], const pg8::Unit& u, int) const {
        int t_ = wave * 64 + lane_id(); asm volatile("" : "+v"(t_));
        const int fr = t_ & 15, fq = (t_ >> 4) & 3, wid_ = __builtin_amdgcn_readfirstlane(t_ >> 6), wr = wid_ >> 2, wc = wid_ & 3;
        unsigned char* ws_ = ws; asm volatile("" : "+s"(ws_)); unsigned char* const Y = ws_ + WS_Y; const float* const WL = (const float*)(ws_ + WS_WL);
        const int cnt = aux[AUX_CNT + u.e];
        float wvs[8];
#pragma unroll
        for (int am = 0; am < 8; ++am) { const int idx = u.ml * 256 + (am >> 2) * 128 + wr * 64 + (am & 3) * 16 + fr; wvs[am] = idx < cnt ? WL[(size_t)u.e * CAP + idx] : 0.f; }
#pragma unroll
        for (int ai = 0; ai < 2; ++ai)
#pragma unroll
            for (int m = 0; m < 4; ++m) { const int lr = ai * 128 + wr * 64 + m * 16 + fr, idx = u.ml * 256 + lr; const size_t slot = (size_t)u.pm * 256 + lr;
                if (idx < cnt) { const float wv = wvs[ai * 4 + m];
#pragma unroll
                    for (int bj = 0; bj < 2; ++bj) { const f32x4 v0 = acc[ai][bj][m][0] * wv, v1 = acc[ai][bj][m][1] * wv;
                        *(GAS v2u*)(Y + slot * DM + u.pn * 256 + bj * 128 + wc * 32 + 8 * fq) = (v2u){pg8::pk4_fp8(v0[0], v0[1], v0[2], v0[3]), pg8::pk4_fp8(v1[0], v1[1], v1[2], v1[3])}; } } }
    }
};
#ifndef MK_DUMP
#define MK_DUMP 0
#endif
#if MK_DUMP
__device__ __forceinline__ void dump_phase(Frame& F, int which) {
    const size_t n = (size_t)M * DM; const size_t g0 = (size_t)F.vcu * NTHREADS + F.tid, gs = (size_t)F.G * NTHREADS;
    const bf16* HN = (const bf16*)(F.ws + WS_HN); const bf16* PROJ = (const bf16*)(F.ws + WS_PROJ);
    LAS int* aux = (LAS int*)(F.lds + AUX_OFF);
    if (which >= 7) moe_table(F, 0);
    for (size_t i = g0; i < n; i += gs) { const size_t row = i >> 10; const int c = (int)(i & 1023); float v = 0.f;
        if (which == 1 || which == 4) v = bf2f(HN[i]);
        else if (which == 9) v = (c < 512) ? bf2f(HN[i]) : 0.f;
        else if (which == 10) v = (c >= 512) ? bf2f(HN[i]) : 0.f;
        else if (which == 2) v = bf2f(PROJ[row * NPROJ + c]) + bf2f(PROJ[row * NPROJ + 1024 + c]) + bf2f(PROJ[row * NPROJ + 2048 + c]) + bf2f(PROJ[row * NPROJ + 3072 + (c & 511)]);
        else if (which == 3) v = ((const float*)(F.ws + WS_SEG))[i & (4 * 1024 * 1024 - 1)] + ((const float*)(F.ws + WS_CL))[i & (256 * 1024 - 1)];
        else if (which == 5) v = F.out[i];
        else if (which == 6) { const int4 rt = ((const int4*)(F.ws + WS_RT))[row]; v = (c == 0) ? (float)rt.x : (c == 1) ? (float)rt.z : (c == 2) ? ((const float*)(F.ws + WS_WL))[(size_t)rt.x * CAP + rt.y] : (c == 3) ? ((const float*)(F.ws + WS_WL))[(size_t)rt.z * CAP + rt.w] : (float)(F.ws + WS_HN)[row * (size_t)DM * XSZ + c]; }
        else if (which == 7) { const int4 rt = ((const int4*)(F.ws + WS_RT))[row]; const size_t s0 = (size_t)(256 * aux[AUX_TS + rt.x] + rt.y), s1 = (size_t)(256 * aux[AUX_TS + rt.z] + rt.w);
            v = (c < 512) ? (float)(F.ws + WS_A1)[(s0 * DE + c) * XSZ] : (float)(F.ws + WS_A1)[(s1 * DE + (c - 512)) * XSZ]; }
        else if (which == 8) { const int4 rt = ((const int4*)(F.ws + WS_RT))[row]; const size_t s0 = (size_t)(256 * aux[AUX_TS + rt.x] + rt.y), s1 = (size_t)(256 * aux[AUX_TS + rt.z] + rt.w);
            v = (float)(F.ws + WS_Y)[s0 * DM + c] + (float)(F.ws + WS_Y)[s1 * DM + c]; }
        if (which != 5) F.out[i] = v; }
}
#endif
__device__ __forceinline__ void moe_fill_tok(Frame& F, const ExpertOrder1& S) {
    LAS int* aux = (LAS int*)(F.lds + AUX_OFF); const int* TOK = (const int*)(F.ws + WS_TOK);
    pg8::Unit u;
    for (int ui = 0; ui < AUX_MAXU && S.next(ui, u); ++ui)
        if (F.tid < 256) { const int cnt = aux[AUX_CNT + u.e]; int idx = u.ml * 256 + F.tid; idx = idx < cnt ? idx : cnt - 1;
            aux[AUX_TOK + ui * 256 + F.tid] = TOK[(size_t)u.e * CAP + idx]; }
    __syncthreads();
}
typedef __attribute__((address_space(4))) const struct Args* KArgsP;
__device__ __forceinline__ const float* kin_ptr(KArgsP ka, int i);
constexpr int PH_PER_LAYER = 8, N_PHASES = 1 + DEPTH * PH_PER_LAYER + 1;
struct Args { const float* in[14]; float* out; unsigned char* ws; int ph_lo, ph_hi; };
__device__ __forceinline__ int bx_opaque() { int c_ = (int)blockIdx.x; asm volatile("" : "+s"(c_)); return c_; }
__device__ __forceinline__ const float* kin_ptr(KArgsP ka, int i) { KArgsP k_ = ka; asm volatile("" : "+s"(k_)); return k_->in[i]; }
__global__ void __launch_bounds__(NTHREADS, 2) trunk_fwd(Args args) {
    extern __shared__ __attribute__((aligned(16))) unsigned char lds[];
    Frame F;
    F.lds = (LAS unsigned char*)lds;
    F.MISC = (volatile LAS unsigned*)(F.lds + MISC_OFF);
    F.tid = threadIdx.x; F.lane = F.tid & 63; F.wave = __builtin_amdgcn_readfirstlane(F.tid >> 6);
    F.G = gridDim.x; { const int bx = blockIdx.x; F.vcu = (F.G % 8 == 0) ? (bx % 8) * (F.G / 8) + bx / 8 : bx; }
    F.ws = args.ws; F.out = args.out; F.ctl = (gu32*)(args.ws + WS_CTL);
    for (int u = F.tid; u < 128; u += NTHREADS) ((LAS unsigned*)(F.lds + MISC_OFF))[u] = 0u;
    __syncthreads();
    if (F.lane == 0) F.MISC[64 + (__builtin_amdgcn_s_getreg(0x2804) & 63)] = (unsigned)F.wave;
    __syncthreads();
    XcdBarrier bar; bar.w0 = 0; bar.bar = (unsigned*)(F.ctl + CW_BAR); bar.x = 0; bar.st = nullptr;
    if (!MK_MULTI) bar = xcd_barrier_post((unsigned*)(F.ctl + CW_BAR), F.MISC + 8, F.wave == 0 ? 1u : 0u);
    typedef __attribute__((address_space(4))) const Args* KArgs;
    const KArgs ka = (KArgs)__builtin_amdgcn_kernarg_segment_ptr();
#define KIN(i) (kin_ptr(ka, i))
    const int lo = args.ph_lo, hi = args.ph_hi;
#ifndef MK_PHMASK
#define MK_PHMASK 0x3ff
#endif
#define IN(k) (lo <= (k) && (k) < hi)
#define EN(j) ((MK_PHMASK >> (j)) & 1)
#ifndef MK_REPMASK
#define MK_REPMASK 0
#endif
#define REP(j) for (int rep_ = 0; rep_ < 1 + ((MK_REPMASK >> (j)) & 1); ++rep_)
#define SEAM(k) do { if (IN(k) && IN((k) + 1)) xcd_barrier(bar); } while (0)
#ifndef MK_WAVESRC
#define MK_WAVESRC 1
#endif
#define WAVE_NOW() (MK_WAVESRC == 0 ? __builtin_amdgcn_readfirstlane((int)threadIdx.x >> 6) : __builtin_amdgcn_readfirstlane((int)F.MISC[64 + (__builtin_amdgcn_s_getreg(0x2804) & 63)]))
#define REFRESH() do { F.wave = WAVE_NOW(); int t_ = F.wave * 64 + lane_id(); asm volatile("" : "+v"(t_)); F.tid = t_; F.lane = t_ & 63; \
        unsigned char* w_ = args.ws; float* o_ = args.out; asm volatile("" : "+s"(w_), "+s"(o_)); F.ws = w_; F.out = o_; F.ctl = (gu32*)(w_ + WS_CTL); \
        int g_ = F.G, v_ = F.vcu; asm volatile("" : "+s"(g_), "+s"(v_)); F.G = g_; F.vcu = v_; } while (0)

    if (EN(0) && IN(0)) REP(0) { REFRESH(); p0_prologue(F, KIN(I_WIN), KIN(I_WOUT), KIN(I_WEG), KIN(I_WEU), KIN(I_WED), KIN(I_WRG), KIN(I_WRE)); }

    for (int layer = 0; layer < DEPTH; ++layer) {
        const int pb = 1 + layer * PH_PER_LAYER;
        const float* xin = KIN(I_X);
        if (EN(1) && IN(pb + 0)) { REFRESH();
            if (layer == 0) REP(1) pa_phase<false, false>(F, xin, F.out, KIN(I_NMIX), 0, KIN(I_WIN), KIN(I_FB), 0);
            else pa_phase<true, false>(F, xin, F.out, KIN(I_NMIX) + layer * DM, layer, nullptr, KIN(I_FB) + layer * FH, layer - 1);
        }
        SEAM(pb + 0);
#if MK_DUMP
        if (layer == 0 && MK_DUMP == 1) { REFRESH(); dump_phase(F, 1); return; }
#endif
        if (EN(2) && IN(pb + 1)) { REFRESH();
            pg8::DenseOrder<M / 256, NPROJ / 256> S; S.init(F.ws + WS_HN, (const bf16*)(F.ws + WS_WIN) + (size_t)layer * NPROJ * DM, DM, F.G, bx_opaque());
            EpiProj E{F.wave, (bf16*)(F.ws + WS_PROJ), (const float*)(F.ws + WS_ROT), (unsigned*)(F.ctl + CW_KB + layer * 512)};
#ifdef MK_EPIPROBE
            pg8::gemm_phase<EpiProj, pg8::DenseOrder<M / 256, NPROJ / 256>, true>(F.lds, DM, S, E, F.wave);
            { EpiProjT<true> E2{F.wave, (bf16*)(F.ws + WS_PROJ), (const float*)(F.ws + WS_ROT), (unsigned*)(F.ctl + CW_KB + layer * 512)}; __syncthreads(); pg8::gemm_phase<EpiProjT<true>, pg8::DenseOrder<M / 256, NPROJ / 256>, true>(F.lds, DM, S, E2, F.wave); }
#else
            REP(2) pg8::gemm_phase<EpiProj, pg8::DenseOrder<M / 256, NPROJ / 256>, true>(F.lds, DM, S, E, F.wave);
#endif
        }
        SEAM(pb + 1);
#if MK_DUMP
        if (layer == 0 && MK_DUMP == 2) { REFRESH(); dump_phase(F, 2); return; }
#endif
        if (EN(3) && IN(pb + 2)) REP(3) { REFRESH(); ret_passA(F); cl_tables(F);
            if (MK_CHAIN4 && !MK_MULTI) { asm volatile("s_waitcnt vmcnt(0)" ::: "memory"); if (lane_id() == 0) (void)__hip_atomic_fetch_add(F.ctl + CW_PC0 + layer, 1u, RLX_AGENT); } }
        if (!(MK_CHAIN4 && !MK_MULTI)) SEAM(pb + 2);
#if MK_DUMP
        if (layer == 0 && MK_DUMP == 3) { REFRESH(); dump_phase(F, 3); return; }
#endif
        if (EN(4) && IN(pb + 3)) { REFRESH();
            REP(4) pc_phase(F, layer, layer + 2 * rep_, KIN(I_WIN), KIN(I_WOUT), KIN(I_WEG), KIN(I_WEU), KIN(I_WED));
        }
        SEAM(pb + 3);
#if MK_DUMP
        if (layer == 0 && (MK_DUMP == 4 || MK_DUMP == 9 || MK_DUMP == 10)) { REFRESH(); dump_phase(F, MK_DUMP); return; }
#endif
        if (EN(5) && IN(pb + 4)) { REFRESH();
            pg8::DenseOrder<M / 256, DM / 256, MSZ> S; S.init(F.ws + WS_HN, F.ws + WS_WOUT + (size_t)layer * DM * DM * MSZ, DM, F.G, bx_opaque());
            EpiRes E{F.wave, layer == 0 ? xin : nullptr, (bf16*)(F.ws + WS_XB), (float*)(F.ws + WS_ROWSS)};
            for (int rep_ = 0; rep_ < 1 + (layer == 0 ? ((MK_REPMASK >> 5) & 1) : 0); ++rep_) pg8::gemm_phase<EpiRes, pg8::DenseOrder<M / 256, DM / 256, MSZ>, true, MSZ>(F.lds, DM, S, E, F.wave);
        }
        SEAM(pb + 4);
#if MK_DUMP
        if (layer == 0 && MK_DUMP == 5) { REFRESH(); dump_phase(F, 5); return; }
#endif
        if (EN(6) && IN(pb + 5)) { REFRESH(); pf_phase(F, layer, KIN(I_BRG) + layer * NG, KIN(I_BRE) + layer * NE, KIN(I_NFFN) + layer * DM); }
        SEAM(pb + 5);
#if MK_DUMP
        if (layer == 0 && MK_DUMP == 6) { REFRESH(); dump_phase(F, 6); return; }
#endif
        if (EN(7) && IN(pb + 6)) { REFRESH();
            moe_table(F, layer);
            ExpertOrder1 S{(const char*)(F.ws + WS_HN), (const char*)(F.ws + WS_W1) + (size_t)layer * NE * 1024 * 1024 * XSZ, (LAS int*)(F.lds + AUX_OFF), F.G, F.vcu};
            moe_fill_tok(F, S);
            EpiSwiGLU E{F.wave, F.ws + WS_A1, (unsigned*)(F.ctl + CW_RDY + layer * MAXTILES * 64)};
            REP(7) pg8::gemm_phase<EpiSwiGLU, ExpertOrder1, true, XSZ>(F.lds, DM, S, E, F.wave);
        }
        if (!MK_CHAIN) SEAM(pb + 6);
#if MK_DUMP
        if (layer == 0 && MK_DUMP == 7) { REFRESH(); dump_phase(F, 7); return; }
#endif
        if (EN(8) && IN(pb + 7)) { REFRESH();
            if (MK_MULTI) moe_table(F, layer);
            ExpertOrder2 S{(const char*)(F.ws + WS_A1), (const char*)(F.ws + WS_W2) + (size_t)layer * NE * 1024 * DE * XSZ, (LAS int*)(F.lds + AUX_OFF), F.G, F.vcu, (const unsigned*)(F.ctl + CW_RDY + layer * MAXTILES * 64), (unsigned*)(F.ctl + CW_BAR + XB_TMO)};
            EpiDown E{F.wave, F.ws, (LAS int*)(F.lds + AUX_OFF)};
            REP(8) pg8::gemm_phase<EpiDown, ExpertOrder2, true, XSZ>(F.lds, DE, S, E, F.wave);
        }
        SEAM(pb + 7);
#if MK_DUMP
        if (layer == 0 && MK_DUMP == 8) { REFRESH(); dump_phase(F, 8); return; }
#endif
    }
    if (EN(9) && IN(N_PHASES - 1)) REP(9) { REFRESH(); pa_phase<true, true>(F, F.out, F.out, KIN(I_NFIN), 0, nullptr, nullptr, DEPTH - 1); }
#undef IN
#undef SEAM
}

extern "C" void kernel_launch(void* const* d_in, const int* in_sizes, int n_in, void* d_out, int out_size, void* d_ws, size_t ws_size, hipStream_t stream) {
    static int grid = 0;
    if (grid == 0) {
        if (n_in != 14 || in_sizes[0] != M * DM || out_size != M * DM || ws_size < WS_END) {
            fprintf(stderr, "kernel_launch: unexpected problem (n_in %d, in0 %d, out %d, ws %zu < %zu?); nothing launched\n", n_in, n_in > 0 ? in_sizes[0] : -1, out_size, ws_size, (size_t)WS_END); grid = -1; return; }
        int dev = 0, cus = 0;
        if (hipGetDevice(&dev) != hipSuccess || hipDeviceGetAttribute(&cus, hipDeviceAttributeMultiprocessorCount, dev) != hipSuccess) { grid = -1; return; }
        if (hipFuncSetAttribute((const void*)trunk_fwd, hipFuncAttributeMaxDynamicSharedMemorySize, LDS_BYTES) != hipSuccess) { fprintf(stderr, "kernel_launch: hipFuncSetAttribute failed\n"); grid = -1; return; }
        int per_cu = 0;
        if (hipOccupancyMaxActiveBlocksPerMultiprocessor(&per_cu, (const void*)trunk_fwd, NTHREADS, LDS_BYTES) != hipSuccess || per_cu < 1)
            fprintf(stderr, "kernel_launch: note: occupancy query reports %d workgroups per CU\n", per_cu);
        (void)hipGetLastError();
        grid = cus;
    }
    if (grid < 0) return;
    if (hipMemsetAsync((char*)d_ws + WS_CTL, 0, CTL_ZERO_BYTES, stream) != hipSuccess) return;
    Args a{};
    for (int i = 0; i < 14; ++i) a.in[i] = (const float*)d_in[i];
    a.out = (float*)d_out; a.ws = (unsigned char*)d_ws;
#if MK_MULTI
    for (int p = 0; p < N_PHASES; ++p) { a.ph_lo = p; a.ph_hi = p + 1; hipLaunchKernelGGL(trunk_fwd, dim3(grid), dim3(NTHREADS), LDS_BYTES, stream, a); }
#else
    a.ph_lo = 0; a.ph_hi = N_PHASES;
    hipLaunchKernelGGL(trunk_fwd, dim3(grid), dim3(NTHREADS), LDS_BYTES, stream, a);
#endif
}
```

```cpp
#define MK_WT 0
#include <hip/hip_runtime.h>
#include <hip/hip_bf16.h>
#include <cstdio>
#include <cstdint>
#include <cmath>

#ifndef MK_DIAG
#define MK_DIAG 0
#endif
#ifndef MK_FP8
#define MK_FP8 1
#endif
#ifndef MK_MIX8
#define MK_MIX8 1
#endif
#ifndef MK_CHAIN
#define MK_CHAIN 1
#endif
#ifndef MK_BARWORK
#define MK_BARWORK 1
#endif
#ifndef MK_MULTI
#define MK_MULTI 0
#endif

constexpr int BATCH = 8, SEQ = 4096, DM = 1024, M = BATCH * SEQ, DEPTH = 2;
constexpr int FH = 8, FD = 64, RH = 4, RD = 128;
constexpr int INW = 3592;
constexpr int NPROJ = 3584;
constexpr int PQ = 0, PK = 512, PV = 1024, PRQ = 1536, PRK = 2048, PRV = 2560, PRG = 3072;
constexpr int SRC_FQ = 0, SRC_FK = 512, SRC_FV = 1024, SRC_FF = 1536, SRC_RQ = 1544, SRC_RK = 2056, SRC_RV = 2568, SRC_RG = 3080;
constexpr int NE = 32, NG = 4, EPG = 8, DE = 512;
constexpr float RMS_EPS = 1e-6f;
constexpr int NWAVES = 8, NTHREADS = 512;
constexpr float MIX_SCALE = MK_MIX8 ? 8.f : 1.f;
constexpr int MSZ = MK_MIX8 ? 1 : 2;
constexpr int XSZ = MK_FP8 ? 1 : 2;
constexpr int CAP = 32768;
constexpr int MAXTILES = 288;
constexpr int SLOTS = MAXTILES * 256;

constexpr size_t MiB = 1u << 20;
constexpr size_t WS_CTL = 0, CTL_ZERO_BYTES = 1 * MiB;
constexpr size_t WS_RFR = 512 * 1024;
constexpr int RFR_N = 32 * 3 * 64;
constexpr size_t WS_WFP = 768 * 1024;
constexpr size_t WS_ROT = 1 * MiB;
constexpr size_t WS_LOGF = 3 * MiB;
constexpr size_t WS_ROWSS = 4 * MiB;
constexpr size_t WS_RT = 6 * MiB;
constexpr size_t WS_TOK = 7 * MiB;
constexpr size_t WS_WL = 11 * MiB;
constexpr size_t WS_SEG = 15 * MiB;
constexpr size_t WS_WIN = 31 * MiB;
constexpr size_t WS_WOUT = 45 * MiB;
constexpr size_t WS_W1 = 49 * MiB;
constexpr size_t WS_W2 = 177 * MiB;
constexpr size_t WS_HN = 241 * MiB;
constexpr size_t WS_PROJ = 305 * MiB;
constexpr size_t WS_A1 = WS_PROJ;
constexpr size_t WS_Y = WS_PROJ + 72 * MiB;
constexpr size_t WS_CL = 529 * MiB;
constexpr size_t WS_END = 530 * MiB;
constexpr size_t WS_XB = WS_W1 + 64 * MiB;
static_assert(MK_FP8 == 1, "WS_XB overlays the bf16-only half of WS_W1");
static_assert(WS_Y + (size_t)SLOTS * 1024 * 2 <= WS_END && WS_PROJ + (size_t)M * NPROJ * 2 <= WS_END, "d_ws map");
constexpr int CW_TMO = 0, CW_CODE = 1;
constexpr int CW_CNT = 64;
constexpr int CW_RDY = 65536;
constexpr int CW_CVQ = 56;
constexpr int CW_Q = 48;
constexpr int CW_KB = 8192;
constexpr int CW_DIAG = 256;
constexpr int CW_BAR = 4096;

constexpr int RING_BYTES = 131072;
constexpr int AUX_OFF = RING_BYTES;
constexpr int AUX_BYTES = 16384 - 512;
constexpr int MISC_OFF = RING_BYTES + AUX_BYTES;
constexpr int LDS_BYTES = 147456;

#define GAS __attribute__((address_space(1)))
#define LAS __attribute__((address_space(3)))
typedef unsigned short bf16;
typedef unsigned v4u __attribute__((ext_vector_type(4)));
typedef unsigned v2u __attribute__((ext_vector_type(2)));
typedef float f32x4 __attribute__((ext_vector_type(4)));
typedef float f32x2 __attribute__((ext_vector_type(2)));
typedef float f32x16 __attribute__((ext_vector_type(16)));
typedef short bf16x8 __attribute__((ext_vector_type(8)));
typedef short s16x4 __attribute__((ext_vector_type(4)));
typedef GAS unsigned gu32;
#define RLX_AGENT __ATOMIC_RELAXED, __HIP_MEMORY_SCOPE_AGENT
#define LDS_WAIT() asm volatile("s_waitcnt lgkmcnt(0)" ::: "memory")
#define VM_WAIT() asm volatile("s_waitcnt vmcnt(0)" ::: "memory")
__device__ __forceinline__ unsigned f2bf(float f) { unsigned u = __builtin_bit_cast(unsigned, f); return (u + 0x7fffu + ((u >> 16) & 1u)) >> 16; }
typedef float f32x2h_t __attribute__((ext_vector_type(2))); typedef __bf16 bf16x2h_t __attribute__((ext_vector_type(2)));
__device__ __forceinline__ unsigned pk2(float lo, float hi) { const f32x2h_t v = {lo, hi}; return __builtin_bit_cast(unsigned, __builtin_convertvector(v, bf16x2h_t)); }
__device__ __forceinline__ float eps_s() { float e = 1e-6f; asm volatile("" : "+s"(e)); return e; }
__device__ __forceinline__ float bf2f(unsigned b) { return __builtin_bit_cast(float, b << 16); }
#ifndef MK_V0TID
#define MK_V0TID 0
#endif
#if MK_V0TID
__device__ __forceinline__ int lane_id() { return (int)(threadIdx.x & 63u); }
#else
__device__ __forceinline__ int lane_id() { int l; asm volatile("v_mbcnt_lo_u32_b32 %0, -1, 0\n\tv_mbcnt_hi_u32_b32 %0, -1, %0" : "=v"(l)); return l; }
#endif
__device__ __forceinline__ int shx_i(int v, int o) { return __builtin_amdgcn_ds_bpermute((lane_id() ^ o) << 2, v); }
__device__ __forceinline__ float shx_f(float v, int o) { return __builtin_bit_cast(float, __builtin_amdgcn_ds_bpermute((lane_id() ^ o) << 2, __builtin_bit_cast(int, v))); }
__device__ __forceinline__ float shup_f(float v, int o) { const int l = lane_id(); return __builtin_bit_cast(float, __builtin_amdgcn_ds_bpermute((l >= o ? l - o : l) << 2, __builtin_bit_cast(int, v))); }
__device__ __forceinline__ float wave_sum(float v) {
    const int l = lane_id();
#pragma unroll
    for (int o = 1; o < 64; o <<= 1) v += __builtin_bit_cast(float, __builtin_amdgcn_ds_bpermute((l ^ o) << 2, __builtin_bit_cast(int, v)));
    return v;
}
__device__ __forceinline__ float silu_f(float v) { return v * __builtin_amdgcn_rcpf(1.f + __builtin_amdgcn_exp2f(-1.4426950408889634f * v)); }
__host__ __device__ __forceinline__ float ret_lg2(int h) { return h == 0 ? -0.04580368846654892f : h == 1 ? -0.022720076143741608f : h == 2 ? -0.011315313167870045f : -0.00564656313508749f; }
namespace pg8 {
constexpr int BM = 256, BK = 64, HALF = 128, HTB = HALF * BK * 2  , STAGE_BYTES = 8 * HTB, NXCD = 8, WGM = 8;
__host__ __device__ __forceinline__ int lds_byte(int r, int c) { const int st = (r >> 4) * 2 + (c >> 5), rr = r & 15, cc = c & 31, ob = rr * 64 + cc * 2; return st * 1024 + (ob ^ (((ob >> 9) & 1) << 5)); }
__host__ __device__ __forceinline__ void stage_rc(int b, int& R, int& C) { const int st = b / 1024, sb = b % 1024, swz = sb ^ (((sb >> 9) & 1) << 5); R = (st >> 1) * 16 + swz / 64; C = (st & 1) * 32 + (swz % 64) / 2; }
__host__ __device__ __forceinline__ int perm32(int rho) { const int n = rho >> 4, i = rho & 15; return 8 * (i >> 2) + 4 * n + (i & 3); }

struct Unit { int pm, pn, e, ml; };

template <int NM, int NN, int ESZ = 2> struct DenseOrder {
    static constexpr bool GATHER = false;
    const char* A; const char* Bt; int K; int G, c;
    __device__ void init(const void* A_, const void* Bt_, int K_, int G_, int c_) { A = (const char*)A_; Bt = (const char*)Bt_; K = K_; G = G_; c = c_; }
    __device__ __forceinline__ bool next(int i, Unit& u) const {
        constexpr int nwg = NM * NN, q = nwg / NXCD, r = nwg % NXCD, nig = WGM * NN;
        if (i * G + c >= nwg) return false;
#ifndef MK_ROTUNITS
#define MK_ROTUNITS 1
#endif
#if MK_ROTUNITS
        constexpr bool rot_ok = (nwg % 256) == 0;
        const int ii = (rot_ok && G == 256) ? (i + (c & 7) * (MK_ROTUNITS)) % (nwg / 256) : i;
#else
        const int ii = i;
#endif
        const int L = ii * G + c;
        int wgid = L; { const int xcd = wgid % NXCD, off = wgid / NXCD; wgid = (xcd < r ? xcd * (q + 1) : r * (q + 1) + (xcd - r) * q) + off; }
        const int gid = wgid / nig, fm = gid * WGM, gsz = (NM - fm) < WGM ? (NM - fm) : WGM;
        static_assert(NM % WGM == 0, "row tiles come in full groups of 8 (gsz == 8)");
        u.pm = fm + ((wgid % nig) % WGM); u.pn = (wgid % nig) / WGM; u.e = 0; u.ml = 0; (void)gsz; return true;
    }
    __device__ __forceinline__ const char* a_base(const Unit& u) const { return A + (size_t)u.pm * BM * K * ESZ; }
    __device__ __forceinline__ const char* b_base(const Unit& u) const { return Bt + (size_t)u.pn * BM * K * ESZ; }
    __device__ __forceinline__ unsigned a_row_off(int, int) const { return 0u; }
    __device__ __forceinline__ void a_ready(const Unit&, int) const {}
};

typedef int v4i_t __attribute__((ext_vector_type(4)));
__device__ __forceinline__ unsigned pk4_fp8(float a, float b, float c, float d) { int r = __builtin_amdgcn_cvt_pk_fp8_f32(a, b, 0, false); r = __builtin_amdgcn_cvt_pk_fp8_f32(c, d, r, true); return (unsigned)r; }
typedef float f32x2c_t __attribute__((ext_vector_type(2))); typedef __bf16 bf16x2c_t __attribute__((ext_vector_type(2)));
__device__ __forceinline__ unsigned cvt_pk_bf16(float lo, float hi) { const f32x2c_t v = {lo, hi}; const bf16x2c_t b = __builtin_convertvector(v, bf16x2c_t); return __builtin_bit_cast(unsigned, b); }

template <class Epi, class Sched, bool ALIGN_EPI, int ESZ = 2>
__device__ __forceinline__ void gemm_phase(LAS unsigned char* lds, const int K, const Sched& S, const Epi& E, const int wave_) {
    int tid = wave_ * 64 + lane_id(); asm volatile("" : "+v"(tid));
    const int wid = __builtin_amdgcn_readfirstlane(tid >> 6), lane = tid & 63, wr = wid >> 2, wc = wid & 3, fr = lane & 15, fq = lane >> 4;
    int Kop = K; asm volatile("" : "+s"(Kop));
    const int KB = Kop * ESZ, nt = KB / (BK * 2);
    int RA[2], CA[2]; unsigned voffB[2];
#pragma unroll
    for (int i = 0; i < 2; ++i) { int R, C; stage_rc(tid * 16 + i * 8192, R, C); const int Rb = Epi::PERM ? ((R & ~31) + perm32(R & 31)) : R;
        RA[i] = R; CA[i] = C; voffB[i] = (unsigned)(Rb * KB + C * 2); }
    const size_t kstep = (size_t)(BK * 2);
    const size_t ah1 = Sched::GATHER ? 0 : (size_t)HALF * KB;
    const size_t hstep = (size_t)HALF * KB;
    const unsigned ldsw = (unsigned)wid * 1024u;
    const unsigned ldsb = (unsigned)(__UINTPTR_TYPE__)lds + ldsw;
    const int aoff = lds_byte(wr * 64 + fr, fq * 8), boff = lds_byte(wc * 32 + fr, fq * 8);
#define PG8_SA(b, h) (((b) * 2 + (h)) * HTB)
#define PG8_SB(b, h) ((4 + (b) * 2 + (h)) * HTB)
#ifndef MK_STAGE_ASM
#define MK_STAGE_ASM 1
#endif
#if MK_STAGE_ASM
#define PG8_STAGE(bufoff, gbase, voff) do { _Pragma("unroll") for (int _i = 0; _i < 2; ++_i) { unsigned keep_; \
        asm volatile("s_mov_b32 %0, m0\n\ts_mov_b32 m0, %3\n\ts_nop 0\n\tglobal_load_lds_dwordx4 %1, %2\n\ts_mov_b32 m0, %0" : "=&s"(keep_) \
                     : "v"((voff)[_i]), "s"((const void*)(gbase)), "s"(ldsb + (unsigned)((bufoff) + _i * 8192)) : "memory"); } } while (0)
#else
#define PG8_STAGE(bufoff, gbase, voff) do { _Pragma("unroll") for (int _i = 0; _i < 2; ++_i) \
        __builtin_amdgcn_global_load_lds((const unsigned*)((const char*)(gbase) + (voff)[_i]), (LAS unsigned*)(lds + (bufoff) + ldsw + _i * 8192), 16, 0, 0); } while (0)
#endif
#define PG8_LDA(dst, b, h) do { _Pragma("unroll") for (int m = 0; m < 4; ++m) _Pragma("unroll") for (int k = 0; k < 2; ++k) dst[m][k] = *(const LAS bf16x8*)(lds + PG8_SA(b, h) + aoff + m * 2048 + k * 1024); } while (0)
#define PG8_LDB(dst, b, h) do { _Pragma("unroll") for (int n = 0; n < 2; ++n) _Pragma("unroll") for (int k = 0; k < 2; ++k) dst[n][k] = *(const LAS bf16x8*)(lds + PG8_SB(b, h) + boff + n * 2048 + k * 1024); } while (0)
#define PG8_CAT(x, y) __builtin_shufflevector(__builtin_bit_cast(v4i_t, x), __builtin_bit_cast(v4i_t, y), 0, 1, 2, 3, 4, 5, 6, 7)
#define PG8_MMA(ai, bj, At, Bt) do { __builtin_amdgcn_s_setprio(1); if constexpr (ESZ == 2) { _Pragma("unroll") for (int m = 0; m < 4; ++m) _Pragma("unroll") for (int n = 0; n < 2; ++n) _Pragma("unroll") for (int k = 0; k < 2; ++k) \
        acc[ai][bj][m][n] = __builtin_amdgcn_mfma_f32_16x16x32_bf16(Bt[n][k], At[m][k], acc[ai][bj][m][n], 0, 0, 0); } else { _Pragma("unroll") for (int m = 0; m < 4; ++m) _Pragma("unroll") for (int n = 0; n < 2; ++n) \
        acc[ai][bj][m][n] = __builtin_amdgcn_mfma_scale_f32_16x16x128_f8f6f4(PG8_CAT(Bt[n][0], Bt[n][1]), PG8_CAT(At[m][0], At[m][1]), acc[ai][bj][m][n], 0, 0, 0, 0, 0, 0); } \
        __builtin_amdgcn_s_setprio(0); } while (0)
#define PG8_WAIT_V(n) asm volatile("s_waitcnt vmcnt(" #n ")" ::: "memory")
#define PG8_WAIT_L(n) asm volatile("s_waitcnt lgkmcnt(" #n ")" ::: "memory")
#define PG8_BAR __builtin_amdgcn_s_barrier()
#define PG8_SCHED __builtin_amdgcn_sched_barrier(0)
#define PG8_SETV(v, ui_, u_) do { _Pragma("unroll") for (int _h = 0; _h < 2; ++_h) _Pragma("unroll") for (int _i = 0; _i < 2; ++_i) \
        v[_h][_i] = Sched::GATHER ? (S.a_row_off(ui_, _h * HALF + RA[_i]) + (unsigned)CA[_i] * 2u) : ((unsigned)(RA[_i] * KB + CA[_i] * 2)); } while (0)
    Unit cur, nxt; int ui = 0;
    if (!S.next(0, cur)) return;
    f32x4 acc[2][2][4][2];
#pragma unroll
    for (int a = 0; a < 2; ++a)
#pragma unroll
        for (int b = 0; b < 2; ++b)
#pragma unroll
            for (int m = 0; m < 4; ++m)
#pragma unroll
                for (int n = 0; n < 2; ++n) acc[a][b][m][n] = (f32x4){0.f, 0.f, 0.f, 0.f};
    bf16x8 At[4][2], B0[2][2], B1[2][2];
    unsigned vc[2][2], vn[2][2];
    PG8_SETV(vc, 0, cur);
    const char* cA = S.a_base(cur); const char* cB = S.b_base(cur);
    S.a_ready(cur, wave_);
    PG8_STAGE(PG8_SB(0, 0), cB, voffB); PG8_STAGE(PG8_SB(0, 1), cB + hstep, voffB); PG8_STAGE(PG8_SA(0, 0), cA, vc[0]); PG8_STAGE(PG8_SA(0, 1), cA + ah1, vc[1]);
    if (wr == 1) PG8_BAR;
    PG8_WAIT_V(2); PG8_BAR;
    PG8_STAGE(PG8_SB(1, 0), cB + kstep, voffB); PG8_STAGE(PG8_SA(1, 0), cA + kstep, vc[0]); PG8_STAGE(PG8_SB(1, 1), cB + hstep + kstep, voffB);
    PG8_WAIT_V(6); PG8_BAR;
#ifndef MK_EPIOVL
#define MK_EPIOVL 0
#endif
    bool pre = false;
    for (;;) {
        const bool has_next = S.next(ui + 1, nxt);
        const char* nA = has_next ? S.a_base(nxt) : cA; const char* nB = has_next ? S.b_base(nxt) : cB;
        if (Sched::GATHER) { if (has_next) { PG8_SETV(vn, ui + 1, nxt); } else {
#pragma unroll
            for (int h = 0; h < 2; ++h)
#pragma unroll
                for (int i = 0; i < 2; ++i) vn[h][i] = vc[h][i]; } }
#pragma nounroll
        for (int t = 0; t < nt; t += 2) {
            const bool last = (t == nt - 2);
            const bool skp = MK_EPIOVL && pre && t == 0;
            const char* a1 = cA + (size_t)(t + 1) * kstep;
            const char* a2 = last ? nA : cA + (size_t)(t + 2) * kstep; const char* b2 = last ? nB : cB + (size_t)(t + 2) * kstep;
            const char* a3 = a2 + kstep; const char* b3 = b2 + kstep;
            if (last && has_next) S.a_ready(nxt, wave_);
            PG8_LDB(B0, 0, 0); PG8_LDB(B1, 0, 1); PG8_SCHED; PG8_LDA(At, 0, 0); if (!skp) PG8_STAGE(PG8_SA(1, 1), a1 + ah1, vc[1]);
            if (Sched::GATHER && last) { _Pragma("unroll") for (int h = 0; h < 2; ++h) _Pragma("unroll") for (int i = 0; i < 2; ++i) vc[h][i] = vn[h][i]; }
            if (!skp) PG8_WAIT_V(8); PG8_WAIT_L(0); PG8_BAR; PG8_MMA(0, 0, At, B0); PG8_MMA(0, 1, At, B1); PG8_BAR; PG8_SCHED;
            PG8_LDA(At, 0, 1); PG8_STAGE(PG8_SB(0, 0), b2, voffB); PG8_STAGE(PG8_SB(0, 1), b2 + hstep, voffB); PG8_STAGE(PG8_SA(0, 0), a2, vc[0]);
            if (!skp) PG8_WAIT_V(8); PG8_WAIT_L(0); PG8_BAR; PG8_MMA(1, 0, At, B0); PG8_MMA(1, 1, At, B1); PG8_BAR; PG8_SCHED;
            PG8_LDB(B0, 1, 0); PG8_LDB(B1, 1, 1); PG8_SCHED; PG8_LDA(At, 1, 0); PG8_STAGE(PG8_SA(0, 1), a2 + ah1, vc[1]);
            if (!skp) PG8_WAIT_V(8); PG8_WAIT_L(0); PG8_BAR; PG8_MMA(0, 0, At, B0); PG8_MMA(0, 1, At, B1); PG8_BAR; PG8_SCHED;
            PG8_LDA(At, 1, 1); PG8_STAGE(PG8_SB(1, 0), b3, voffB); PG8_STAGE(PG8_SB(1, 1), b3 + hstep, voffB); PG8_STAGE(PG8_SA(1, 0), a3, vc[0]);
            PG8_WAIT_V(8); PG8_WAIT_L(0); PG8_BAR; PG8_MMA(1, 0, At, B0); PG8_MMA(1, 1, At, B1); PG8_BAR; PG8_SCHED;
        }
        if (MK_EPIOVL && has_next) { PG8_STAGE(PG8_SA(1, 1), nA + kstep + ah1, vc[1]); pre = true; }
        if constexpr (ALIGN_EPI) { if (wr == 0) PG8_BAR; }
        if (MK_EPIOVL) PG8_WAIT_V(0);
        E(acc, cur, ui);
        if (!has_next) break;
#pragma unroll
        for (int a = 0; a < 2; ++a)
#pragma unroll
            for (int b = 0; b < 2; ++b)
#pragma unroll
                for (int m = 0; m < 4; ++m)
#pragma unroll
                    for (int n = 0; n < 2; ++n) acc[a][b][m][n] = (f32x4){0.f, 0.f, 0.f, 0.f};
        cur = nxt; cA = nA; cB = nB; ++ui;
        if constexpr (ALIGN_EPI) { if (wr == 1) PG8_BAR; }
    }
    PG8_WAIT_V(0);
    if constexpr (!ALIGN_EPI) { if (wr == 0) PG8_BAR; }
    PG8_BAR;
#undef PG8_SA
#undef PG8_SB
#undef PG8_STAGE
#undef PG8_LDA
#undef PG8_LDB
#undef PG8_MMA
#undef PG8_CAT
#undef PG8_WAIT_V
#undef PG8_WAIT_L
#undef PG8_BAR
#undef PG8_SCHED
#undef PG8_SETV
}
}
namespace attn_body {
using hb16=__hip_bfloat16;
using u32x4=__attribute__((ext_vector_type(4)))unsigned;
constexpr int NHEAD=FH,D=FD,QP=NPROJ,OP=DM;
constexpr int NW=8,QBLK=32,QB=QBLK*NW,KVBLK=64,NQB=SEQ/QB;
__device__ __forceinline__ int crow(int r,int hi){return (r&3)+8*(r>>2)+4*hi;}
#define SBAR() __builtin_amdgcn_sched_barrier(0)
__device__ __forceinline__ void cmask(f32x16&p0,f32x16&p1,int jb,int qrel,int hi){
  float NEG=-INFINITY; asm volatile("":"+v"(NEG)); int kb=64*jb+4*hi;
  #pragma unroll
  for(int r=0;r<16;++r){int kv=kb+(r&3)+8*(r>>2); if(kv>qrel)p0[r]=NEG; if(kv+32>qrel)p1[r]=NEG;}
}
constexpr int NSLOT=3, SLOTB=8192;
constexpr int LDS_K=0, LDS_V=NSLOT*SLOTB, LDS_WS=2*NSLOT*SLOTB, LDS_OST=LDS_WS+NW*64*4, LDS_BYTES=LDS_OST+NW*4096;
constexpr int LDS_CL=90112, LDS_CLTMP=LDS_CL+SEQ*4;
constexpr float LOG2E=1.4426950408889634f;
#ifndef MK_SKIP
#define MK_SKIP 64
#endif
constexpr int SKIP=MK_SKIP;
constexpr float C2=0.125f*LOG2E;
__device__ __forceinline__ void glds16(const void*gsrc,unsigned lds_dst){unsigned keep;
  asm volatile("s_mov_b32 %0, m0\n\ts_mov_b32 m0, %2\n\ts_nop 0\n\tglobal_load_lds_dwordx4 %1, off\n\ts_mov_b32 m0, %0":"=&s"(keep):"v"(gsrc),"s"(lds_dst):"memory");}
__device__ __forceinline__ float max3f(float a,float b,float c){float r;asm("v_max3_f32 %0, %1, %2, %3":"=v"(r):"v"(a),"v"(b),"v"(c));return r;}
__device__ __forceinline__ float max2f(float a,float b){float r;asm("v_max_f32_e32 %0, %1, %2":"=v"(r):"v"(a),"v"(b));return r;}
__device__ __forceinline__ float fadd_s(float a,float b){float r;asm("v_add_f32_e32 %0, %1, %2":"=v"(r):"v"(a),"v"(b));return r;}
__device__ __forceinline__ float fsub_s(float a,float b){float r;asm("v_sub_f32_e32 %0, %1, %2":"=v"(r):"v"(a),"v"(b));return r;}
typedef float f32x2_t __attribute__((ext_vector_type(2))); typedef __bf16 bf16x2_t __attribute__((ext_vector_type(2)));
__device__ __forceinline__ unsigned cvtpk_s(float lo,float hi){f32x2_t v={lo,hi};bf16x2_t b=__builtin_convertvector(v,bf16x2_t);return __builtin_bit_cast(unsigned,b);}
#define WAIT_BAR(N) asm volatile("s_waitcnt vmcnt(" #N ") lgkmcnt(0)\n\ts_barrier":::"memory")

typedef LAS const char* lds_cptr;
typedef short v4i16_t __attribute__((ext_vector_type(4)));
__device__ __forceinline__ void qkt(f32x16&p0,f32x16&p1,const char*Kslot,const bf16x8*qr,int r32,int hi){
  const char*kb=Kslot+hi*1024+r32*16;
  #pragma unroll
  for(int d0=0;d0<4;++d0){
    const bf16x8 b0=*reinterpret_cast<const bf16x8*>(kb+d0*2048);
    const bf16x8 b1=*reinterpret_cast<const bf16x8*>(kb+d0*2048+512);
    p0=__builtin_amdgcn_mfma_f32_32x32x16_bf16(b0,qr[d0],p0,0,0,0);p1=__builtin_amdgcn_mfma_f32_32x32x16_bf16(b1,qr[d0],p1,0,0,0);}
}
__device__ __forceinline__ void kload8(bf16x8*kf,lds_cptr kp){
  kf[0]=*(const LAS bf16x8*)(kp);      kf[1]=*(const LAS bf16x8*)(kp+512);
  kf[2]=*(const LAS bf16x8*)(kp+2048); kf[3]=*(const LAS bf16x8*)(kp+2560);
  kf[4]=*(const LAS bf16x8*)(kp+4096); kf[5]=*(const LAS bf16x8*)(kp+4608);
  kf[6]=*(const LAS bf16x8*)(kp+6144); kf[7]=*(const LAS bf16x8*)(kp+6656);
}
__device__ __forceinline__ void kload2(bf16x8*kf,lds_cptr kp,int j){ kf[2*j]=*(const LAS bf16x8*)(kp+j*2048); kf[2*j+1]=*(const LAS bf16x8*)(kp+j*2048+512); }
__device__ __forceinline__ s16x4 vtr(lds_cptr p){ return __builtin_bit_cast(s16x4,__builtin_amdgcn_ds_read_tr16_b64_v4i16((LAS v4i16_t*)p)); }
__device__ __forceinline__ float rowmax(const f32x16&p0,const f32x16&p1){
  float a=max3f(p0[0],p0[1],p1[0]),b=max3f(p0[2],p0[3],p1[1]);a=max3f(a,p1[2],p1[3]);
  #pragma unroll
  for(int r=4;r<16;r+=4){a=max3f(a,p0[r],p0[r+1]);b=max3f(b,p0[r+2],p0[r+3]);a=max3f(a,p1[r],p1[r+1]);b=max3f(b,p1[r+2],p1[r+3]);}
  const float m=max2f(a,b);
  auto rr=__builtin_amdgcn_permlane32_swap(__float_as_uint(m),__float_as_uint(m),false,false);
  return max2f(__uint_as_float(rr[0]),__uint_as_float(rr[1]));
}
__device__ __forceinline__ void pv(f32x16*o,int vb,bf16x8 pa0,bf16x8 pa1,bf16x8 pa2,bf16x8 pa3){
  #pragma unroll
  for(int d0=0;d0<2;++d0){s16x4 lo[4],hi[4];
    #pragma unroll
    for(int ks=0;ks<4;++ks){
      asm volatile("ds_read_b64_tr_b16 %0,%1 offset:%c2":"=&v"(lo[ks]):"v"(vb),"i"(d0*4096+ks*1024):"memory");
      asm volatile("ds_read_b64_tr_b16 %0,%1 offset:%c2":"=&v"(hi[ks]):"v"(vb),"i"(d0*4096+ks*1024+512):"memory");}
    asm volatile("s_waitcnt lgkmcnt(0)":::"memory");SBAR();
    #define PK(k) (bf16x8){lo[k][0],lo[k][1],lo[k][2],lo[k][3],hi[k][0],hi[k][1],hi[k][2],hi[k][3]}
    o[d0]=__builtin_amdgcn_mfma_f32_32x32x16_bf16(pa0,PK(0),o[d0],0,0,0);
    o[d0]=__builtin_amdgcn_mfma_f32_32x32x16_bf16(pa1,PK(1),o[d0],0,0,0);
    o[d0]=__builtin_amdgcn_mfma_f32_32x32x16_bf16(pa2,PK(2),o[d0],0,0,0);
    o[d0]=__builtin_amdgcn_mfma_f32_32x32x16_bf16(pa3,PK(3),o[d0],0,0,0);
    #undef PK
  }
}
__device__ __forceinline__ void bias_init(f32x16&C0,f32x16&C1,lds_cptr cl3,int T,int hi,float cqm){
  const LAS f32x4* cp=(const LAS f32x4*)(cl3+(64*T+4*hi)*4);
  #pragma unroll
  for(int g=0;g<4;++g){ const f32x4 a=cp[2*g], b=cp[2*g+8];
    #pragma unroll
    for(int i=0;i<4;++i){ C0[4*g+i]=cqm-a[i]; C1[4*g+i]=cqm-b[i]; } }
}

__device__ __forceinline__ void bias_load(f32x16&C0,f32x16&C1,lds_cptr cl3,int T,int hi){
  const LAS f32x4* cp=(const LAS f32x4*)(cl3+(64*T+4*hi)*4);
  #pragma unroll
  for(int g=0;g<4;++g){ const f32x4 a=cp[2*g], b=cp[2*g+8];
    #pragma unroll
    for(int i=0;i<4;++i){ C0[4*g+i]=a[i]; C1[4*g+i]=b[i]; } }
}
#ifndef ATTN_STORE16
#define ATTN_STORE16(p,v) (*(u32x4*)(p)=(v))
#endif
template<int THRL> __device__ __forceinline__ void attn_unit(int b,int h,int qb,const hb16*Q,const hb16*__restrict__ K,const hb16*__restrict__ V,hb16*O,char*shm,float Kb,int wave_,gu32*qctr,int&qn){
  int tid=wave_*64+lane_id(); asm volatile("":"+v"(tid));
  const int lane=tid&63,r32=lane&31,hi=lane>>5; const int wid=__builtin_amdgcn_readfirstlane(tid>>6);
  const long rowbase=(long)b*SEQ; const int q0=qb*QB;
  const hb16*Qw=Q+(rowbase+q0+wid*QBLK)*QP+h*D;
  const hb16*Kh=K+rowbase*QP+h*D,*Vh=V+rowbase*QP+h*D;
  const unsigned lds0=(unsigned)(uintptr_t)shm;
  float*wsf=(float*)(shm+LDS_WS)+wid*64;
  const hb16*ksrc=Kh+(long)lane*QP+wid*8;
  const hb16*vsrc=Vh+(long)(16*(wid&3)+(lane>>2))*QP+(wid>>2)*32+(lane&3)*8;
  const unsigned kdst=lds0+LDS_K+wid*1024, vdst=lds0+LDS_V+wid*1024;
  const int NT0=(q0+QB)/KVBLK; int NT=NT0;
  #define TILE(i) (((i)<4)?(NT0-4+(i)):(NT0-1-(i)))
  #define DMA_K(t,slot) glds16(ksrc+(long)TILE(t)*KVBLK*QP,(unsigned)__builtin_amdgcn_readfirstlane(kdst+(slot)))
  #define DMA_V(t,slot) glds16(vsrc+(long)TILE(t)*KVBLK*QP,(unsigned)__builtin_amdgcn_readfirstlane(vdst+(slot)))
  const char*Kbase=shm+LDS_K; bf16x8 kf[8];
  const lds_cptr shm3=(lds_cptr)shm; const lds_cptr kp0=shm3+LDS_K+hi*1024+r32*16; const lds_cptr vp0=shm3+LDS_V+((lane>>4)&1)*32+(lane&3)*8+(4*hi+((lane&15)>>2))*64;
  const lds_cptr cl3=shm3+LDS_CL;
  DMA_K(0,0);DMA_V(0,0);DMA_K(1,SLOTB);
  bf16x8 qr[4];
  #pragma unroll
  for(int d0=0;d0<4;++d0)qr[d0]=*reinterpret_cast<const bf16x8*>(&Qw[(long)r32*QP+d0*16+hi*8]);
  const int qrel=wid*QBLK+r32;
  float mhat=0.f,l_reg=0.f;f32x16 o[2];o[0]=f32x16{};o[1]=f32x16{};
  float cqm=*(const LAS float*)(cl3+(q0+qrel)*4);
  #define CMASK(P0,P1,t) do{ if((t)<4)cmask(P0,P1,(t),qrel,hi); }while(0)
  bool resc=false;
  #define START(P0,P1) do{ const float rm=rowmax(P0,P1); resc=false; \
    { const float dl=rm; mhat=fadd_s(mhat,dl); cqm=fsub_s(cqm,dl); \
      _Pragma("unroll") for(int r=0;r<16;++r){P0[r]=fsub_s(P0[r],dl);P1[r]=fsub_s(P1[r],dl);} } \
    _Pragma("unroll") for(int r=0;r<16;++r)P0[r]=__builtin_amdgcn_exp2f(P0[r]); }while(0)
  #define RESC() do{ if(resc){ asm volatile("s_waitcnt lgkmcnt(0)":::"memory"); \
      _Pragma("unroll") for(int d_=0;d_<2;++d_) _Pragma("unroll") for(int r=0;r<16;++r)o[d_][r]*=wsf[crow(r,hi)]; } }while(0)
  f32x16 pA0,pA1,pB0,pB1;
  int sl_prev=0,sl_cur=0,sl_next=SLOTB;
  #define ROT() do{sl_prev=sl_cur;sl_cur=sl_next;sl_next=(sl_next==(NSLOT-1)*SLOTB)?0:sl_next+SLOTB;}while(0)
  DMA_K(2,2*SLOTB);
  bias_init(pA0,pA1,cl3,TILE(0),hi,cqm);
  WAIT_BAR(3);
  qkt(pA0,pA1,Kbase,qr,r32,hi);asm volatile("s_nop 15\n\ts_nop 7":"+v"(pA0),"+v"(pA1));CMASK(pA0,pA1,0);
  START(pA0,pA1);
  _Pragma("unroll") for(int r=0;r<16;++r)pA1[r]=__builtin_amdgcn_exp2f(pA1[r]);
  bias_init(pB0,pB1,cl3,TILE(1),hi,cqm);
  WAIT_BAR(0);
  DMA_K(3,0);DMA_V(1,SLOTB);
  ROT();
  kload8(kf,kp0+sl_cur);
  WAIT_BAR(2);
  s16x4 vlo[8],vhi[8]; u32x4 pw0,pw1,pw2,pw3;
  #define PKW(P,B) cvtpk_s(P[B],P[B+1])
  #define PAF(k) __builtin_bit_cast(bf16x8,pw##k)
  #define VFR(i) (bf16x8){vlo[i][0],vlo[i][1],vlo[i][2],vlo[i][3],vhi[i][0],vhi[i][1],vhi[i][2],vhi[i][3]}
  #define PIN(x) asm volatile("":"+v"(x))
  #define MX3(a,b,c) __builtin_fmaxf(__builtin_fmaxf((a),(b)),(c))
  #define GAPA(MF,A0,A1,A2,A3,W0,W1,PW) do{ MF; sacc+=A0; sacc+=A1; sacc+=A2; sacc+=A3; PIN(sacc); W0; W1; PIN(PW); SBAR(); }while(0)
  #define EX(v) __builtin_amdgcn_exp2f(v)
  #define GAPB(MF,X,B) do{ MF; X[B]=EX(X[B]); X[B+1]=EX(X[B+1]); X[B+2]=EX(X[B+2]); X[B+3]=EX(X[B+3]); PIN(X); SBAR(); }while(0)
  #define BS1(Q,i) Q[i]=cqm-Q[i]
  #define GAPBS(MF,X,B,G,Q0,i0,Q1,i1,Q2,i2,Q3,i3,Q4,i4,Q5,i5) do{ MF; X[B]=EX(X[B]); X[B+1]=EX(X[B+1]); X[B+2]=EX(X[B+2]); X[B+3]=EX(X[B+3]); PIN(X); \
      if(G){ BS1(Q0,i0); BS1(Q1,i1); BS1(Q2,i2); BS1(Q3,i3); BS1(Q4,i4); if((i5)!=(i4)){BS1(Q5,i5);} PIN(Q0); PIN(Q5); } SBAR(); }while(0)
  #define VRD(i) do{ vlo[i]=vtr(vp_+(((i)>>2)*4096+((i)&3)*1024)); vhi[i]=vtr(vp_+(((i)>>2)*4096+((i)&3)*1024+512)); }while(0)
  #define KRD(G,j) do{ if(G){ kload2(kf,kp0+sl_next,j); SBAR(); } }while(0)
  #define STEP(C0,C1,P0,P1,t,GK,GV,GL) do{ SBAR(); \
    const lds_cptr vp_=vp0+sl_prev; \
    VRD(0); SBAR(); float sacc=(P0[0]+P0[1]); \
    GAPA(C0=__builtin_amdgcn_mfma_f32_32x32x16_bf16(kf[0],qr[0],C0,0,0,0), P0[2],P0[3],P0[4],P0[5],     pw0[0]=PKW(P0,0), pw0[1]=PKW(P0,2), pw0); \
    VRD(4); SBAR(); GAPA(C1=__builtin_amdgcn_mfma_f32_32x32x16_bf16(kf[1],qr[0],C1,0,0,0), P0[6],P0[7],P0[8],P0[9],     pw0[2]=PKW(P0,4), pw0[3]=PKW(P0,6), pw0); \
    VRD(1); SBAR(); GAPA(C0=__builtin_amdgcn_mfma_f32_32x32x16_bf16(kf[2],qr[1],C0,0,0,0),   P0[10],P0[11],P0[12],P0[13], pw1[0]=PKW(P0,8), pw1[1]=PKW(P0,10), pw1); \
    VRD(5); SBAR(); GAPA(C1=__builtin_amdgcn_mfma_f32_32x32x16_bf16(kf[3],qr[1],C1,0,0,0),   P0[14],P0[15],P1[0],P1[1],   pw1[2]=PKW(P0,12),pw1[3]=PKW(P0,14), pw1); \
    VRD(2); SBAR(); GAPA(C0=__builtin_amdgcn_mfma_f32_32x32x16_bf16(kf[4],qr[2],C0,0,0,0),   P1[2],P1[3],P1[4],P1[5],     pw2[0]=PKW(P1,0), pw2[1]=PKW(P1,2), pw2); \
    VRD(6); SBAR(); GAPA(C1=__builtin_amdgcn_mfma_f32_32x32x16_bf16(kf[5],qr[2],C1,0,0,0),   P1[6],P1[7],P1[8],P1[9],     pw2[2]=PKW(P1,4), pw2[3]=PKW(P1,6), pw2); \
    VRD(3); SBAR(); GAPA(C0=__builtin_amdgcn_mfma_f32_32x32x16_bf16(kf[6],qr[3],C0,0,0,0),   P1[10],P1[11],P1[12],P1[13], pw3[0]=PKW(P1,8), pw3[1]=PKW(P1,10), pw3); \
    VRD(7); SBAR(); GAPA(C1=__builtin_amdgcn_mfma_f32_32x32x16_bf16(kf[7],qr[3],C1,0,0,0),   P1[14],P1[15],0.f,0.f,       pw3[2]=PKW(P1,12),pw3[3]=PKW(P1,14), pw3); \
    l_reg+=sacc; \
    if(GK){DMA_K((t)+3,sl_cur);} if(GV){DMA_V((t)+1,sl_next);} \
    CMASK(C0,C1,t); \
    { float a=MX3(C0[0],C0[1],C1[0]),b=MX3(C0[2],C0[3],C1[1]); a=MX3(a,C1[2],C1[3]); \
      _Pragma("unroll") for(int r=4;r<16;r+=4){a=MX3(a,C0[r],C0[r+1]);b=MX3(b,C0[r+2],C0[r+3]);a=MX3(a,C1[r],C1[r+1]);b=MX3(b,C1[r+2],C1[r+3]);} \
      float rm=__builtin_fmaxf(a,b); { auto rr=__builtin_amdgcn_permlane32_swap(__float_as_uint(rm),__float_as_uint(rm),false,false); rm=__builtin_fmaxf(__uint_as_float(rr[0]),__uint_as_float(rr[1])); } \
      resc=false; \
      if(__builtin_expect(__any(rm>(float)THRL),0)){ const float dl=__builtin_fmaxf(rm,0.f); mhat+=dl; cqm-=dl; \
        _Pragma("unroll") for(int r=0;r<16;++r){C0[r]-=dl;C1[r]-=dl;} \
        const float f=__builtin_amdgcn_exp2f(-dl); l_reg*=f; { int r_=r32; asm volatile("":"+v"(r_)); if(hi==0)wsf[r_]=f; } resc=true; } } \
    SBAR(); \
    if(GL){ bias_load(P0,P1,cl3,TILE((t)+1),hi); } SBAR(); \
    GAPB(o[0]=__builtin_amdgcn_mfma_f32_32x32x16_bf16(PAF(0),VFR(0),o[0],0,0,0), C0,0); \
    GAPB(o[1]=__builtin_amdgcn_mfma_f32_32x32x16_bf16(PAF(0),VFR(4),o[1],0,0,0), C0,4); \
    KRD(GL,0); GAPBS(o[0]=__builtin_amdgcn_mfma_f32_32x32x16_bf16(PAF(1),VFR(1),o[0],0,0,0), C0,8,  GL,P0,0,P0,1,P0,2,P0,3,P0,4,P0,5); \
    KRD(GL,1); GAPBS(o[1]=__builtin_amdgcn_mfma_f32_32x32x16_bf16(PAF(1),VFR(5),o[1],0,0,0), C0,12, GL,P0,6,P0,7,P0,8,P0,9,P0,10,P0,11); \
    KRD(GL,2); GAPBS(o[0]=__builtin_amdgcn_mfma_f32_32x32x16_bf16(PAF(2),VFR(2),o[0],0,0,0), C1,0,  GL,P0,12,P0,13,P0,14,P0,15,P1,0,P1,0); \
    KRD(GL,3); GAPBS(o[1]=__builtin_amdgcn_mfma_f32_32x32x16_bf16(PAF(2),VFR(6),o[1],0,0,0), C1,4,  GL,P1,1,P1,2,P1,3,P1,4,P1,5,P1,5); \
    GAPBS(o[0]=__builtin_amdgcn_mfma_f32_32x32x16_bf16(PAF(3),VFR(3),o[0],0,0,0), C1,8,  GL,P1,6,P1,7,P1,8,P1,9,P1,10,P1,10); \
    GAPBS(o[1]=__builtin_amdgcn_mfma_f32_32x32x16_bf16(PAF(3),VFR(7),o[1],0,0,0), C1,12, GL,P1,11,P1,12,P1,13,P1,14,P1,15,P1,15); \
    }while(0)
  #define ENDW(tt) do{ if((tt)+3<NT){WAIT_BAR(2);} else if((tt)+2<NT){WAIT_BAR(1);} else {WAIT_BAR(0);} }while(0)
  int t;
  for(t=1;t<5&&t+1<NT;t+=2){
    STEP(pB0,pB1,pA0,pA1,t,(t+3<NT),(t+1<NT),(t+1<NT));       ENDW(t);   RESC(); ROT();
    if(t==3)
    {  float bqk;
      { float qs=0.f;
        #pragma unroll
        for(int d0=0;d0<4;++d0){
          #pragma unroll
          for(int j=0;j<8;++j){const float v=__uint_as_float(((unsigned)(unsigned short)qr[d0][j])<<16);qs+=v*v;} }
        auto rr=__builtin_amdgcn_permlane32_swap(__float_as_uint(qs),__float_as_uint(qs),false,false);
        bqk=__builtin_amdgcn_sqrtf(__uint_as_float(rr[0])+__uint_as_float(rr[1]))*1.0001f*Kb; }

      const float X=cqm+bqk+(float)(SKIP+THRL);
      int lo=0,hi_=NT0-4;
      while(lo<hi_){ const int mid=(lo+hi_)>>1; const float c=*(const LAS float*)(cl3+(64*mid+63)*4); if(c<=X)hi_=mid; else lo=mid+1; }
      #pragma unroll
      for(int o_=1;o_<64;o_<<=1){ const int u_=shx_i(lo,o_); lo=u_<lo?u_:lo; }
      if(lane==0)*(LAS int*)(cl3+SEQ*4+wid*4)=lo; }
    STEP(pA0,pA1,pB0,pB1,t+1,(t+4<NT),(t+2<NT),(t+2<NT));     ENDW(t+1); RESC(); ROT();
  }
  if(NT0>4)
    { int tm=NT0;
      #pragma unroll
      for(int w=0;w<8;++w){ const int v_=*(const LAS int*)(cl3+SEQ*4+w*4); tm=v_<tm?v_:tm; }
      tm=__builtin_amdgcn_readfirstlane(tm);
      int ne=4+((NT0-4-tm)>0?(NT0-4-tm):0); ne=ne<8?8:ne; ne=(ne+1)&~1; NT=ne<NT0?ne:NT0; }
  #undef CMASK
  #define CMASK(P0,P1,t) do{}while(0)
  for(;t+5<NT;t+=2){
    STEP(pB0,pB1,pA0,pA1,t,true,true,true);     WAIT_BAR(2); RESC(); ROT();
    STEP(pA0,pA1,pB0,pB1,t+1,true,true,true);   WAIT_BAR(2); RESC(); ROT();
  }
  for(;t+1<NT;t+=2){
    STEP(pB0,pB1,pA0,pA1,t,(t+3<NT),(t+1<NT),(t+1<NT));       ENDW(t);   RESC(); ROT();
    STEP(pA0,pA1,pB0,pB1,t+1,(t+4<NT),(t+2<NT),(t+2<NT));     ENDW(t+1); RESC(); ROT();
  }
  #undef CMASK
  #define CMASK(P0,P1,t) do{ if((t)<4)cmask(P0,P1,(t),qrel,hi); }while(0)
  STEP(pB0,pB1,pA0,pA1,NT-1,false,false,false); RESC();
  { float sacc=pB0[0]+pB0[1]; _Pragma("unroll") for(int r=2;r<16;++r)sacc+=pB0[r]; _Pragma("unroll") for(int r=0;r<16;++r)sacc+=pB1[r]; l_reg+=sacc;
    pw0=(u32x4){PKW(pB0,0),PKW(pB0,2),PKW(pB0,4),PKW(pB0,6)};pw1=(u32x4){PKW(pB0,8),PKW(pB0,10),PKW(pB0,12),PKW(pB0,14)};pw2=(u32x4){PKW(pB1,0),PKW(pB1,2),PKW(pB1,4),PKW(pB1,6)};pw3=(u32x4){PKW(pB1,8),PKW(pB1,10),PKW(pB1,12),PKW(pB1,14)};
    const int vb0=(int)(lds0+LDS_V)+((lane>>4)&1)*32+(lane&3)*8+(4*hi+((lane&15)>>2))*64;
    SBAR(); pv(o,vb0+sl_cur,PAF(0),PAF(1),PAF(2),PAF(3)); }
  #undef PKW
  #undef PAF
  #undef VFR
  #undef PIN
  #undef MX3
  #undef GAPA
  #undef GAPB
  #undef EX
  #undef VRD
  #undef KRD
  #undef STEP
  #undef ENDW
  if(wid==0&&lane==0) qn=(int)__hip_atomic_fetch_add(qctr,1u,RLX_AGENT);
  {auto rr=__builtin_amdgcn_permlane32_swap(__float_as_uint(l_reg),__float_as_uint(l_reg),false,false);l_reg=__uint_as_float(rr[0])+__uint_as_float(rr[1]);}
  if(hi==0)wsf[32+r32]=l_reg;asm volatile("s_waitcnt lgkmcnt(0)":::"memory");
  float rli[16];
  #pragma unroll
  for(int r=0;r<16;++r)rli[r]=__builtin_amdgcn_rcpf(wsf[32+crow(r,hi)]);
  hb16*Ow=O+(rowbase+q0+wid*QBLK)*OP+h*D;
  { hb16*stg=(hb16*)(shm+LDS_OST)+wid*2048;
    #pragma unroll
    for(int r=0;r<16;++r){const int orow=crow(r,hi);
      #pragma unroll
      for(int d0=0;d0<2;++d0)stg[orow*64+d0*32+r32]=__float2bfloat16(o[d0][r]*rli[r]);}
    asm volatile("s_waitcnt lgkmcnt(0)":::"memory");
    #pragma unroll
    for(int i=0;i<4;++i){const int row=i*8+(lane>>3),ch=lane&7; const u32x4 v=*(const u32x4*)(stg+row*64+ch*8);
#if MK_MIX8
      { unsigned char*O8=(unsigned char*)O+(size_t)(rowbase+q0+wid*QBLK+row)*OP+h*D+ch*8;
        v2u w8; w8.x=pg8::pk4_fp8(bf2f(v.x&0xffffu)*MIX_SCALE,bf2f(v.x>>16)*MIX_SCALE,bf2f(v.y&0xffffu)*MIX_SCALE,bf2f(v.y>>16)*MIX_SCALE); w8.y=pg8::pk4_fp8(bf2f(v.z&0xffffu)*MIX_SCALE,bf2f(v.z>>16)*MIX_SCALE,bf2f(v.w&0xffffu)*MIX_SCALE,bf2f(v.w>>16)*MIX_SCALE);
        *(GAS v2u*)O8=w8; }
#else
      ATTN_STORE16(Ow+(long)row*OP+ch*8,v);
#endif
    } }
  asm volatile("s_waitcnt lgkmcnt(0)\n\ts_barrier":::"memory");
  #undef DMA_K
  #undef DMA_V
  #undef TILE
  #undef CMASK
  #undef START
  #undef RESC
  #undef ROT
}
__device__ __forceinline__ void fox_cumsum(const float*logf,int b,int h,char*shm,int wave_){
  int tid=wave_*64+lane_id(); asm volatile("":"+v"(tid));
  const int lane=tid&63,wid=tid>>6;
  LAS float*cl=(LAS float*)((lds_cptr)shm+LDS_CL); LAS float*tmp=(LAS float*)((lds_cptr)shm+LDS_CLTMP);
  float v[8];
  #pragma unroll
  for(int i=0;i<8;++i)v[i]=logf[((size_t)b*SEQ+8*tid+i)*FH+h];
  #pragma unroll
  for(int i=1;i<8;++i)v[i]+=v[i-1];
  const float tot=v[7]; float s=tot;
  #pragma unroll
  for(int o=1;o<64;o<<=1){const float u=shup_f(s,o); if(lane>=o)s+=u;}
  __syncthreads();
  if(lane==63)tmp[wid]=s;
  __syncthreads();
  float base=0.f;
  for(int w=0;w<wid;++w)base+=tmp[w];
  const float excl=base+s-tot;
  #pragma unroll
  for(int i=0;i<8;++i)cl[8*tid+i]=(excl+v[i])*LOG2E;
  __syncthreads();
}
#undef SBAR
#undef WAIT_BAR
}
#define XB_TMO      128
#define XB_XCNT(j)  (256  + 64 * (j))
#define XB_XSUB(j)  (1280 + 64 * (j))
#define XB_XGEN(j)  (2304 + 64 * (j))
#define XB_TOP      3328
#define XB_TOPGEN   3392
#define XCD_BAR_WORDS 3456
#define XB_SPIN_CAP (1u << 18)

__device__ __forceinline__ unsigned xb_ld(unsigned* p)              { return __hip_atomic_load(p, __ATOMIC_RELAXED, __HIP_MEMORY_SCOPE_AGENT); }
__device__ __forceinline__ unsigned xb_add(unsigned* p, unsigned v) { return __hip_atomic_fetch_add(p, v, __ATOMIC_RELAXED, __HIP_MEMORY_SCOPE_AGENT); }
__device__ __forceinline__ unsigned xb_xcc_id() { return (unsigned)__builtin_amdgcn_s_getreg((3 << 11) | 20) & 0xFu; }
#ifndef MK_BARNAP
#define MK_BARNAP 0
#endif
#if MK_BARNAP
#define XB_NAP() __builtin_amdgcn_s_sleep(1)
#else
#define XB_NAP() do {} while (0)
#endif
#define XB_SPIN(cond, bar) do { unsigned _sp = 0; while (cond) { XB_NAP(); \
    if ((++_sp & 255u) == 0u) { if (xb_ld(&(bar)[XB_TMO])) break; if (_sp > XB_SPIN_CAP) { atomicAdd(&(bar)[XB_TMO], 1u); break; } } } } while (0)

struct XcdBarrier {
    unsigned w0;
    unsigned* bar; unsigned x;
    volatile LAS unsigned* st;
};

__device__ __forceinline__ XcdBarrier xcd_barrier_post(unsigned* bar, volatile LAS unsigned* st, unsigned w0) {
    XcdBarrier b; b.w0 = w0; b.bar = bar; b.x = xb_xcc_id(); b.st = st;
    if (w0 && lane_id() == 0) (void)xb_add(&bar[XB_XCNT(b.x)], 1u);
    return b;
}
__device__ __forceinline__ void xcd_barrier_complete(unsigned* bar, unsigned x, unsigned& nloc, unsigned& nx) {
    const unsigned G = gridDim.x * gridDim.y * gridDim.z;
    unsigned sum, cnt, mine, sp = 0u;
    for (;;) {
        sum = 0u; cnt = 0u; mine = 0u;
#pragma unroll
        for (unsigned j = 0; j < 16; ++j) { const unsigned c = xb_ld(&bar[XB_XCNT(j)]); sum += c; cnt += (c > 0u) ? 1u : 0u; }
        if (sum == G) { mine = xb_ld(&bar[XB_XCNT(x)]); break; }
        __builtin_amdgcn_s_sleep(1);
        if ((++sp & 255u) == 0u) { if (xb_ld(&bar[XB_TMO])) break; if (sp > XB_SPIN_CAP) { atomicAdd(&bar[XB_TMO], 1u); break; } }
    }
    nloc = mine > 0u ? mine : 1u; nx = cnt > 0u ? cnt : 1u;
}

__device__ __forceinline__ void xcd_barrier(const XcdBarrier& b) {
    asm volatile("s_waitcnt vmcnt(0)" ::: "memory");
    __syncthreads();
    if (b.w0 && lane_id() == 0) {
        unsigned* bar = b.bar; asm volatile("" : "+s"(bar));
        __builtin_amdgcn_s_waitcnt(0);
        unsigned nloc = b.st[0], nx = b.st[1];
        if (nloc == 0u) { xcd_barrier_complete(bar, b.x, nloc, nx); b.st[0] = nloc; b.st[1] = nx; }
        const unsigned old = xb_add(&bar[XB_XSUB(b.x)], 1u);
        const unsigned gen = old / nloc;
        if (old + 1u == (gen + 1u) * nloc) {
            __builtin_amdgcn_fence(__ATOMIC_RELEASE, "agent");
            asm volatile("s_waitcnt vmcnt(0)" ::: "memory");
            const unsigned og = xb_add(&bar[XB_TOP], 1u);
            const unsigned tg = og / nx;
            if (og + 1u == (tg + 1u) * nx) xb_add(&bar[XB_TOPGEN], 1u);
            else XB_SPIN(xb_ld(&bar[XB_TOPGEN]) == tg, bar);
            __builtin_amdgcn_fence(__ATOMIC_ACQUIRE, "agent");
            xb_add(&bar[XB_XGEN(b.x)], 1u);
            asm volatile("s_waitcnt vmcnt(0)" ::: "memory");
        } else {
            XB_SPIN(xb_ld(&bar[XB_XGEN(b.x)]) == gen, bar);
            __builtin_amdgcn_fence(__ATOMIC_ACQUIRE, "agent");
            asm volatile("s_waitcnt vmcnt(0)" ::: "memory");
        }
    }
    __syncthreads();
}

__device__ __forceinline__ int xcd_barrier_arrive(const XcdBarrier& b, bool may_work) {
    asm volatile("s_waitcnt vmcnt(0)" ::: "memory");
    __syncthreads();
    if (b.w0 && lane_id() == 0) {
        unsigned* bar = b.bar; asm volatile("" : "+s"(bar));
        __builtin_amdgcn_s_waitcnt(0);
        unsigned nloc = b.st[0], nx = b.st[1];
        if (nloc == 0u) { xcd_barrier_complete(bar, b.x, nloc, nx); b.st[0] = nloc; b.st[1] = nx; }
        const unsigned old = xb_add(&bar[XB_XSUB(b.x)], 1u);
        const unsigned gen = old / nloc;
        b.st[4] = 0u;
        if (old + 1u == (gen + 1u) * nloc) {
            __builtin_amdgcn_fence(__ATOMIC_RELEASE, "agent");
            asm volatile("s_waitcnt vmcnt(0)" ::: "memory");
            const unsigned og = xb_add(&bar[XB_TOP], 1u);
            const unsigned tg = og / nx;
            if (og + 1u == (tg + 1u) * nx) xb_add(&bar[XB_TOPGEN], 1u);
            else XB_SPIN(xb_ld(&bar[XB_TOPGEN]) == tg, bar);
            __builtin_amdgcn_fence(__ATOMIC_ACQUIRE, "agent");
            xb_add(&bar[XB_XGEN(b.x)], 1u);
            asm volatile("s_waitcnt vmcnt(0)" ::: "memory");
        } else if (may_work && (old - gen * nloc) * 4u < nloc * 3u) {
            b.st[4] = 1u; b.st[5] = gen;
        } else {
            XB_SPIN(xb_ld(&bar[XB_XGEN(b.x)]) == gen, bar);
            __builtin_amdgcn_fence(__ATOMIC_ACQUIRE, "agent");
            asm volatile("s_waitcnt vmcnt(0)" ::: "memory");
        }
    }
    __syncthreads();
    return (int)b.st[4];
}
__device__ __forceinline__ bool xcd_barrier_released(const XcdBarrier& b) {
    __syncthreads();
    if (b.w0 && lane_id() == 0) { unsigned* bar = b.bar; asm volatile("" : "+s"(bar)); b.st[4] = (xb_ld(&bar[XB_XGEN(b.x)]) != b.st[5]) ? 2u : 1u; }
    __syncthreads();
    return b.st[4] == 2u;
}
__device__ __forceinline__ void xcd_barrier_finish(const XcdBarrier& b) {
    if (b.w0 && lane_id() == 0) { unsigned* bar = b.bar; asm volatile("" : "+s"(bar)); const unsigned gen = b.st[5];
        XB_SPIN(xb_ld(&bar[XB_XGEN(b.x)]) == gen, bar);
        __builtin_amdgcn_fence(__ATOMIC_ACQUIRE, "agent");
        asm volatile("s_waitcnt vmcnt(0)" ::: "memory"); }
    __syncthreads();
}
struct Frame {
    LAS unsigned char* lds;
    volatile LAS unsigned* MISC;
    gu32* ctl;
    int tid, lane, wave;
    int vcu, G;
    float* out; unsigned char* ws;
};
enum { I_X = 0, I_NMIX, I_WIN, I_FB, I_WOUT, I_NFFN, I_WRG, I_BRG, I_WRE, I_BRE, I_WEG, I_WEU, I_WED, I_NFIN };

__device__ __forceinline__ void p0_item(const float* W, int pitch, int k0, int c0, bf16* WT, int Kd, int drow0, int dmul, LAS float* scr, int lane) {
    const int lc = 4 * (lane & 15), lr = lane >> 4;
    f32x4 v[16];
#pragma unroll
    for (int i = 0; i < 16; ++i) v[i] = *(const GAS f32x4*)(W + (size_t)(k0 + lr + 4 * i) * pitch + c0 + lc);
#pragma unroll
    for (int i = 0; i < 16; ++i) { LAS float* s = scr + (lr + 4 * i) * 65 + lc; s[0] = v[i].x; s[1] = v[i].y; s[2] = v[i].z; s[3] = v[i].w; }
    LDS_WAIT(); asm volatile("" ::: "memory");
    const int c = lane & 7;
#pragma unroll
    for (int j = 0; j < 8; ++j) { const int n = (lane >> 3) + 8 * j; const LAS float* s = scr + (8 * c) * 65 + n;
        v4u o; o.x = pk2(s[0 * 65], s[1 * 65]); o.y = pk2(s[2 * 65], s[3 * 65]); o.z = pk2(s[4 * 65], s[5 * 65]); o.w = pk2(s[6 * 65], s[7 * 65]);
        *(GAS v4u*)(WT + (size_t)(drow0 + n * dmul) * Kd + k0 + 8 * c) = o; }
    LDS_WAIT(); asm volatile("" ::: "memory");
}
constexpr float W8_SCALE = 32.f, W8_INV = 1.f / 32.f;
__device__ __forceinline__ void p0_item8(const float* W, int pitch, int k0, int c0, unsigned char* WT8, int Kd, int drow0, LAS float* scr, int lane) {
    const int lc = 4 * (lane & 15), lr = lane >> 4;
    f32x4 v[16];
#pragma unroll
    for (int i = 0; i < 16; ++i) v[i] = *(const GAS f32x4*)(W + (size_t)(k0 + lr + 4 * i) * pitch + c0 + lc);
#pragma unroll
    for (int i = 0; i < 16; ++i) { LAS float* s = scr + (lr + 4 * i) * 65 + lc; s[0] = v[i].x; s[1] = v[i].y; s[2] = v[i].z; s[3] = v[i].w; }
    LDS_WAIT(); asm volatile("" ::: "memory");
    const int c = lane & 7;
#pragma unroll
    for (int j = 0; j < 8; ++j) { const int n = (lane >> 3) + 8 * j; const LAS float* s = scr + (8 * c) * 65 + n;
        v2u o; o.x = pg8::pk4_fp8(s[0 * 65] * W8_SCALE, s[1 * 65] * W8_SCALE, s[2 * 65] * W8_SCALE, s[3 * 65] * W8_SCALE); o.y = pg8::pk4_fp8(s[4 * 65] * W8_SCALE, s[5 * 65] * W8_SCALE, s[6 * 65] * W8_SCALE, s[7 * 65] * W8_SCALE);
        *(GAS v2u*)(WT8 + (size_t)(drow0 + n) * Kd + k0 + 8 * c) = o; }
    LDS_WAIT(); asm volatile("" ::: "memory");
}
__device__ __forceinline__ void sincos_d(double a, double& s, double& c) {
    const double kd = rint(a * 0.6366197723675814);
    double r = fma(-kd, 1.5707963267948966, a); r = fma(-kd, 6.123233995736766e-17, r);
    const int q = (int)((long long)kd & 3);
    const double r2 = r * r;
    const double sp = r * (1.0 + r2 * (-1.0 / 6 + r2 * (1.0 / 120 + r2 * (-1.0 / 5040 + r2 * (1.0 / 362880 + r2 * (-1.0 / 39916800 + r2 * (1.0 / 6227020800.0)))))));
    const double cp = 1.0 + r2 * (-0.5 + r2 * (1.0 / 24 + r2 * (-1.0 / 720 + r2 * (1.0 / 40320 + r2 * (-1.0 / 3628800 + r2 * (1.0 / 479001600 + r2 * (-1.0 / 87178291200.0)))))));
    s = (q == 0) ? sp : (q == 1) ? cp : (q == 2) ? -sp : -cp;
    c = (q == 0) ? cp : (q == 1) ? -sp : (q == 2) ? -cp : sp;
}
constexpr int IT_WIN = 56 * 16, IT_WOUT = 16 * 16, IT_G = 32 * 8 * 16, IT_D = 32 * 16 * 8, IT_LAYER = IT_WIN + IT_WOUT + 2 * IT_G + IT_D;
__device__ __forceinline__ void p0_do_item(Frame& F, int l, int r, const float* w_in, const float* w_out, const float* w_eg, const float* w_eu, const float* w_ed, LAS float* scr) {
    if (r < IT_WIN) { const int kb = r / 56, cb = r % 56, kind = cb >> 3, j = cb & 7;
        int c0, d0, dm = 1;
        if (kind == 0) { c0 = SRC_FQ + 64 * j; d0 = PQ + 64 * j; }
        else if (kind == 1) { c0 = SRC_FK + 64 * j; d0 = PK + 64 * j; }
        else if (kind == 2) { c0 = SRC_FV + 64 * j; d0 = PV + 64 * j; }
        else if (kind == 3) { c0 = SRC_RQ + 64 * j; d0 = PRQ + 128 * (j >> 1) + (j & 1); dm = 2; }
        else if (kind == 4) { c0 = SRC_RK + 64 * j; d0 = PRK + 128 * (j >> 1) + (j & 1); dm = 2; }
        else if (kind == 5) { c0 = SRC_RV + 64 * j; d0 = PRV + 64 * j; }
        else { c0 = SRC_RG + 64 * j; d0 = PRG + 64 * j; }
        p0_item(w_in + (size_t)l * DM * INW, INW, 64 * kb, c0, (bf16*)(F.ws + WS_WIN) + (size_t)l * NPROJ * DM, DM, d0, dm, scr, F.lane); return; }
    r -= IT_WIN;
    if (r < IT_WOUT) { const int kb = r / 16, cb = r % 16;
        if (MK_MIX8) p0_item8(w_out + (size_t)l * DM * DM, DM, 64 * kb, 64 * cb, F.ws + WS_WOUT + (size_t)l * DM * DM, DM, 64 * cb, scr, F.lane);
        else p0_item(w_out + (size_t)l * DM * DM, DM, 64 * kb, 64 * cb, (bf16*)(F.ws + WS_WOUT) + (size_t)l * DM * DM, DM, 64 * cb, 1, scr, F.lane);
        return; }
    r -= IT_WOUT;
    if (r < 2 * IT_G) { const int up = r >= IT_G; if (up) r -= IT_G; const int e = r / 128, q = r % 128, kb = q / 8, cb = q % 8, n0 = 64 * cb;
        if (MK_FP8) p0_item8((up ? w_eu : w_eg) + (size_t)(l * NE + e) * DM * DE, DE, 64 * kb, n0, F.ws + WS_W1 + (size_t)(l * NE + e) * 1024 * 1024, 1024, 256 * (n0 >> 7) + (n0 & 127) + (up ? 128 : 0), scr, F.lane);
        else p0_item((up ? w_eu : w_eg) + (size_t)(l * NE + e) * DM * DE, DE, 64 * kb, n0, (bf16*)(F.ws + WS_W1) + (size_t)(l * NE + e) * 1024 * 1024, 1024, 256 * (n0 >> 7) + (n0 & 127) + (up ? 128 : 0), 1, scr, F.lane);
        return; }
    r -= 2 * IT_G;
    { const int e = r / 128, q = r % 128, kb = q / 16, cb = q % 16;
        if (MK_FP8) p0_item8(w_ed + (size_t)(l * NE + e) * DE * DM, DM, 64 * kb, 64 * cb, F.ws + WS_W2 + (size_t)(l * NE + e) * 1024 * DE, DE, 64 * cb, scr, F.lane);
        else p0_item(w_ed + (size_t)(l * NE + e) * DE * DM, DM, 64 * kb, 64 * cb, (bf16*)(F.ws + WS_W2) + (size_t)(l * NE + e) * 1024 * DE, DE, 64 * cb, 1, scr, F.lane); }
}
constexpr int IT_DENSE = IT_WIN + IT_WOUT, IT_EXP = 2 * IT_G + IT_D;
constexpr int CVT_UNITS = 64, CVT_PER_UNIT = IT_EXP / CVT_UNITS;
static_assert(IT_EXP % CVT_UNITS == 0 && CVT_PER_UNIT % NWAVES == 0, "conversion units");
constexpr int CVT_CHUNK = 8, CVT_NCHUNK = IT_EXP / CVT_CHUNK;
static_assert(IT_EXP % CVT_CHUNK == 0 && CVT_CHUNK == NWAVES, "conversion chunks");
__device__ __forceinline__ bool cvt_pull_chunk(Frame& F, int layer, LAS int* slot, const float* w_eg, const float* w_eu, const float* w_ed) {
    __syncthreads();
    if (F.wave == 0 && lane_id() == 0) *slot = (int)__hip_atomic_fetch_add(F.ctl + CW_CVQ + layer, 1u, RLX_AGENT);
    __syncthreads();
    const int c = __builtin_amdgcn_readfirstlane(*slot);
    if (c >= CVT_NCHUNK) return false;
    { int t_ = F.wave * 64 + lane_id(); asm volatile("" : "+v"(t_)); F.tid = t_; F.lane = t_ & 63; }
    LAS float* scr = (LAS float*)(F.lds) + F.wave * (64 * 65);
    p0_do_item(F, layer, IT_DENSE + c * CVT_CHUNK + F.wave, nullptr, nullptr, w_eg, w_eu, w_ed, scr);
    return true;
}
__device__ __forceinline__ void p0_prologue(Frame& F, const float* w_in, const float* w_out, const float* w_eg, const float* w_eu, const float* w_ed, const float* wrg, const float* wre) {
    LAS float* scr = (LAS float*)(F.lds) + F.wave * (64 * 65);
    const int gw = F.vcu * NWAVES + F.wave, NGW = F.G * NWAVES;
    for (int it = gw; it < IT_DENSE; it += NGW) p0_do_item(F, 0, it, w_in, w_out, w_eg, w_eu, w_ed, scr);
    for (int q = F.vcu * NTHREADS + F.tid; q < DEPTH * RFR_N; q += F.G * NTHREADS) { const int l = q / RFR_N, qq = q % RFR_N, s_ = qq / 192, nt = (qq / 64) % 3, ln = qq & 63, col = 16 * nt + (ln & 15), k0 = 32 * s_ + 8 * (ln >> 4);
        float w[8];
#pragma unroll
        for (int j = 0; j < 8; ++j) w[j] = (col < NG) ? wrg[(size_t)l * DM * NG + (size_t)(k0 + j) * NG + col] : (col < NG + NE) ? wre[(size_t)l * DM * NE + (size_t)(k0 + j) * NE + col - NG] : 0.f;
        ((v4u*)(F.ws + WS_RFR))[q] = (v4u){pk2(w[0], w[1]), pk2(w[2], w[3]), pk2(w[4], w[5]), pk2(w[6], w[7])}; }
    for (int q = F.vcu * NTHREADS + F.tid; q < DEPTH * 4096; q += F.G * NTHREADS) { const int l = q >> 12, ln = (q >> 6) & 63, d = q & 63, j = d >> 4, p_ = (d >> 3) & 1, h = d & 7;
        const float* p0 = w_in + (size_t)l * DM * INW + (size_t)(4 * ln + 256 * j + 2 * p_) * INW + SRC_FF + h;
        ((unsigned*)(F.ws + WS_WFP))[(size_t)l * 4096 + ((d >> 2) * 64 + ln) * 4 + (d & 3)] = pk2(p0[0], p0[INW]); }
    f32x2* rot = (f32x2*)(F.ws + WS_ROT);
    for (int idx = F.vcu * NTHREADS + F.tid; idx < SEQ * 64; idx += F.G * NTHREADS) {
        const int pos = idx >> 6, i = idx & 63;
        const float inv = 1.0f / powf(10000.0f, (float)i / 64.0f);
        const float ang = (float)pos * inv;
        double s, c; sincos_d((double)ang, s, c);
        rot[idx] = (f32x2){(float)c, (float)s};
    }
}

#ifndef MK_REDEAL
#define MK_REDEAL 2
#endif
constexpr int AUX_U2 = 3712;
constexpr int AUX_TS = 0, AUX_CNT = 64, AUX_U = 96, AUX_TOK = 128, AUX_MAXU = 14;
__device__ __forceinline__ void moe_table(Frame& F, int layer) {
    LAS int* aux = (LAS int*)(F.lds + AUX_OFF);
    __syncthreads();
    if (F.wave == 0) {
        const int l = lane_id();
        const int cnt = l < 32 ? (int)__hip_atomic_load(F.ctl + CW_CNT + layer * 32 + (l & 31), RLX_AGENT) : 0;
        const int tiles = (cnt + 255) >> 8;
        int inc = tiles;
#pragma unroll
        for (int o = 1; o < 32; o <<= 1) { const int v = __builtin_amdgcn_ds_bpermute(((l - o) & 63) << 2, inc); if (l >= o) inc += v; }
        const int T = __builtin_amdgcn_readlane(inc, 31), U = 4 * T;
        if (l < 32) { aux[AUX_CNT + l] = cnt; aux[AUX_TS + l] = inc - tiles; }
        if (l == 0) aux[AUX_TS + 32] = T;
        const int j = l & 15, r1 = U % F.G, E = r1 ? F.G - r1 : 0, c = F.vcu;
        int L;
        if (l < 16 || !MK_CHAIN || r1 == 0) L = j * F.G + c;
        else if (c >= r1) L = j < MK_REDEAL ? j * E + (c - r1) : MK_REDEAL * E + (j - MK_REDEAL) * F.G + c;
        else L = MK_REDEAL * E + j * F.G + c;
        const int mt = L >> 2; int e = 0;
#pragma unroll
        for (int x = 0; x < 32; ++x) e += (__builtin_amdgcn_readlane(inc, x) <= mt) ? 1 : 0;
        const int tsb = __builtin_amdgcn_ds_bpermute(((e - 1) & 63) << 2, inc); const int ts_e = e > 0 ? tsb : 0;
        const bool ok = L < U; const int ee = ok ? e : -1, ml = ok ? mt - ts_e : 0;
        if (l < 16) { aux[AUX_U + 2 * j] = ee; aux[AUX_U + 2 * j + 1] = ml; }
        else if (l < 32) { aux[AUX_U2 + 4 * j] = ee; aux[AUX_U2 + 4 * j + 1] = ml; aux[AUX_U2 + 4 * j + 2] = mt; aux[AUX_U2 + 4 * j + 3] = L & 3; }
    }
    __syncthreads();
}

typedef __bf16 bf16x2v __attribute__((ext_vector_type(2)));
#ifndef MK_WT
#define MK_WT 1
#endif
#if MK_WT
#define ST_WT8(p, lo, hi) __hip_atomic_store((GAS unsigned long long*)(p), ((unsigned long long)(hi) << 32) | (unsigned long long)(lo), RLX_AGENT)
#else
#define ST_WT8(p, lo, hi) (*(GAS v2u*)(p) = (v2u){(lo), (hi)})
#endif
template <bool COMBINE, bool FINAL>
__device__ __forceinline__ void pa_row(Frame& F, const f32x4 (&v)[4], const int m, float* xout, const f32x4 (&nw)[4], const unsigned (&wfp)[4][2][8], const float* fb, const int lane) {
        float s = 0.f;
#pragma unroll
        for (int j = 0; j < 4; ++j) s += (v[j].x * v[j].x + v[j].y * v[j].y) + (v[j].z * v[j].z + v[j].w * v[j].w);
        const float rstd = __builtin_amdgcn_rsqf(wave_sum(s) * (1.f / DM) + eps_s());
        if (FINAL) {
#pragma unroll
            for (int j = 0; j < 4; ++j) *(GAS f32x4*)(xout + (size_t)m * DM + 4 * lane + 256 * j) = v[j] * rstd * nw[j];
        } else {
            if (COMBINE) {
                bf16* xb = (bf16*)(F.ws + WS_XB) + (size_t)m * DM;
#pragma unroll
                for (int j = 0; j < 4; ++j) ST_WT8(xb + 4 * lane + 256 * j, pk2(v[j].x, v[j].y), pk2(v[j].z, v[j].w));
            }
            float fa[8];
#pragma unroll
            for (int h = 0; h < 8; ++h) fa[h] = 0.f;
            bf16* hn = (bf16*)(F.ws + WS_HN) + (size_t)m * DM;
#pragma unroll
            for (int j = 0; j < 4; ++j) { const f32x4 hv = v[j] * rstd * nw[j];
                const unsigned h0 = pk2(hv.x, hv.y), h1 = pk2(hv.z, hv.w);
                ST_WT8(hn + 4 * lane + 256 * j, h0, h1);
#pragma unroll
                for (int h = 0; h < 8; ++h) { fa[h] = __builtin_amdgcn_fdot2_f32_bf16(__builtin_bit_cast(bf16x2v, h0), __builtin_bit_cast(bf16x2v, wfp[j][0][h]), fa[h], false);
                    fa[h] = __builtin_amdgcn_fdot2_f32_bf16(__builtin_bit_cast(bf16x2v, h1), __builtin_bit_cast(bf16x2v, wfp[j][1][h]), fa[h], false); } }
            float zt;
            { const bool b0 = (lane & 1) != 0, b1 = (lane & 2) != 0, b2 = (lane & 4) != 0; float t4[4], t2[2];
#pragma unroll
              for (int j = 0; j < 4; ++j) { const float snd = b0 ? fa[2 * j] : fa[2 * j + 1], kp = b0 ? fa[2 * j + 1] : fa[2 * j]; t4[j] = kp + shx_f(snd, 1); }
#pragma unroll
              for (int j = 0; j < 2; ++j) { const float snd = b1 ? t4[2 * j] : t4[2 * j + 1], kp = b1 ? t4[2 * j + 1] : t4[2 * j]; t2[j] = kp + shx_f(snd, 2); }
              { const float snd = b2 ? t2[0] : t2[1], kp = b2 ? t2[1] : t2[0]; zt = kp + shx_f(snd, 4); }
              zt += shx_f(zt, 8); zt += shx_f(zt, 16); zt += shx_f(zt, 32); }
            if (lane < 8) { float z = zt;
                z += fb[lane];
                float ln2_ = 0.6931471805599453f; asm volatile("" : "+v"(ln2_));
                const float lf = fminf(z, 0.f) - ln2_ * __builtin_amdgcn_logf(1.f + __builtin_amdgcn_exp2f(-1.4426950408889634f * fabsf(z)));
                ((float*)(F.ws + WS_LOGF))[(size_t)m * FH + lane] = lf; }
        }
}
template <bool COMBINE, bool FINAL>
__device__ __forceinline__ void pa_phase(Frame& F, const float* xin, float* xout, const float* normw, const int wfp_layer, const float* win0, const float* fb, int prev_layer) {
    const int gw = F.vcu * NWAVES + F.wave, NGW = F.G * NWAVES, lane = F.lane;
    LAS int* aux = (LAS int*)(F.lds + AUX_OFF);
    if (COMBINE && MK_MULTI) moe_table(F, prev_layer);
    f32x4 nw[4];
#pragma unroll
    for (int j = 0; j < 4; ++j) nw[j] = *(const GAS f32x4*)(normw + 4 * lane + 256 * j);
    unsigned wfp[4][2][8];
    if (!FINAL && COMBINE) { const v4u* wp = (const v4u*)(F.ws + WS_WFP) + (size_t)wfp_layer * 1024 + lane;
#pragma unroll
        for (int v = 0; v < 16; ++v) { const v4u q = wp[v * 64]; wfp[v >> 2][(v >> 1) & 1][4 * (v & 1)] = q.x; wfp[v >> 2][(v >> 1) & 1][4 * (v & 1) + 1] = q.y; wfp[v >> 2][(v >> 1) & 1][4 * (v & 1) + 2] = q.z; wfp[v >> 2][(v >> 1) & 1][4 * (v & 1) + 3] = q.w; }
    }
    if (!FINAL && !COMBINE) {
#pragma unroll
        for (int j = 0; j < 4; ++j)
#pragma unroll
            for (int p = 0; p < 2; ++p) { const float* p0 = win0 + (size_t)(4 * lane + 256 * j + 2 * p) * INW + SRC_FF; const float* p1 = p0 + INW;
                const f32x4 a0 = *(const GAS f32x4*)p0, b0 = *(const GAS f32x4*)(p0 + 4), a1 = *(const GAS f32x4*)p1, b1 = *(const GAS f32x4*)(p1 + 4);
                wfp[j][p][0] = pk2(a0.x, a1.x); wfp[j][p][1] = pk2(a0.y, a1.y); wfp[j][p][2] = pk2(a0.z, a1.z); wfp[j][p][3] = pk2(a0.w, a1.w);
                wfp[j][p][4] = pk2(b0.x, b1.x); wfp[j][p][5] = pk2(b0.y, b1.y); wfp[j][p][6] = pk2(b0.z, b1.z); wfp[j][p][7] = pk2(b0.w, b1.w); }
    }
    const unsigned char* Y = F.ws + WS_Y;
    const int4* RT = (const int4*)(F.ws + WS_RT);
    f32x4 vA[4], vB[4], vC[4]; v2u xA[4], xB[4], xC[4]; unsigned yaA[4], ybA[4], yaB[4], ybB[4], yaC[4], ybC[4];
    const bf16* XBp = (const bf16*)(F.ws + WS_XB);
#define PA_LOADROW(VN, XN, YA, YB, mm) do { if ((mm) < M) { \
        if (COMBINE) { _Pragma("unroll") for (int j = 0; j < 4; ++j) XN[j] = *(const GAS v2u*)(XBp + (size_t)(mm) * DM + 4 * lane + 256 * j); } \
        else { _Pragma("unroll") for (int j = 0; j < 4; ++j) VN[j] = *(const GAS f32x4*)(xin + (size_t)(mm) * DM + 4 * lane + 256 * j); } \
        if (COMBINE) { const int4 rt_ = RT[mm]; const size_t s0 = (size_t)(256 * aux[AUX_TS + rt_.x] + rt_.y), s1 = (size_t)(256 * aux[AUX_TS + rt_.z] + rt_.w); \
            _Pragma("unroll") for (int j = 0; j < 4; ++j) { YA[j] = *(const GAS unsigned*)(Y + s0 * DM + 4 * lane + 256 * j); YB[j] = *(const GAS unsigned*)(Y + s1 * DM + 4 * lane + 256 * j); } } } } while (0)
#define PA_ROW(VN, XN, YA, YB, m) do { \
        f32x4 v[4]; \
        if (COMBINE) { _Pragma("unroll") for (int j = 0; j < 4; ++j) { const v2u x_ = XN[j]; v[j] = (f32x4){bf2f(x_.x & 0xffffu), bf2f(x_.x >> 16), bf2f(x_.y & 0xffffu), bf2f(x_.y >> 16)}; } } \
        else { _Pragma("unroll") for (int j = 0; j < 4; ++j) v[j] = VN[j]; } \
        if (COMBINE) { \
            _Pragma("unroll") for (int j = 0; j < 4; ++j) { const int a = (int)YA[j], b = (int)YB[j]; \
                const f32x2 a0 = __builtin_amdgcn_cvt_pk_f32_fp8(a, false), a1 = __builtin_amdgcn_cvt_pk_f32_fp8(a, true), b0 = __builtin_amdgcn_cvt_pk_f32_fp8(b, false), b1 = __builtin_amdgcn_cvt_pk_f32_fp8(b, true); \
                v[j].x += (a0.x + b0.x) * W8_INV; v[j].y += (a0.y + b0.y) * W8_INV; v[j].z += (a1.x + b1.x) * W8_INV; v[j].w += (a1.y + b1.y) * W8_INV; } } \
        PA_LOADROW(VN, XN, YA, YB, (m) + 3 * NGW); \
        pa_row<COMBINE, FINAL>(F, v, m, xout, nw, wfp, fb, lane); } while (0)
    PA_LOADROW(vA, xA, yaA, ybA, gw); PA_LOADROW(vB, xB, yaB, ybB, gw + NGW); PA_LOADROW(vC, xC, yaC, ybC, gw + 2 * NGW);
    for (int m = gw; m < M; m += 3 * NGW) {
        PA_ROW(vA, xA, yaA, ybA, m);
        if (m + NGW < M) PA_ROW(vB, xB, yaB, ybB, m + NGW);
        if (m + 2 * NGW < M) PA_ROW(vC, xC, yaC, ybC, m + 2 * NGW);
    }
}

#undef PA_ROW
#undef PA_LOADROW
template <bool SKIP> struct EpiProjT {
    static constexpr bool PERM = true;
    int wave; bf16* O; const float* rot; unsigned* kb;
    __device__ __forceinline__ void operator()(const f32x4 (&acc)[2][2][4][2], const pg8::Unit& u, int) const {
        int t_ = wave * 64 + lane_id(); asm volatile("" : "+v"(t_));
        const int fr = t_ & 15, fq = (t_ >> 4) & 3, wid_ = __builtin_amdgcn_readfirstlane(t_ >> 6), wr = wid_ >> 2, wc = wid_ & 3;
#if defined(MK_EPIPROBE) && MK_EPIPROBE == 2
        if (SKIP) {
#pragma unroll
            for (int ai = 0; ai < 2; ++ai)
#pragma unroll
                for (int bj = 0; bj < 2; ++bj)
#pragma unroll
                    for (int m = 0; m < 4; ++m) asm volatile("" :: "v"(acc[ai][bj][m][0]), "v"(acc[ai][bj][m][1]));
            return; }
#endif
        const int kind = u.pn >> 1;
        const int row0 = u.pm * 256 + wr * 64 + fr, col0 = u.pn * 256 + wc * 32 + 8 * fq;
        const int i0 = 16 * wc + 4 * fq;
        float lg2h[2]; lg2h[0] = ret_lg2(2 * (u.pn & 1)); lg2h[1] = ret_lg2(2 * (u.pn & 1) + 1);
        float kmx[2] = {0.f, 0.f};
        f32x4 T0[8], T1[8];
        if (kind == 3 || kind == 4) {
#pragma unroll
            for (int am = 0; am < 8; ++am) { const int pos = (row0 + (am >> 2) * 128 + (am & 3) * 16) & (SEQ - 1); const float* tp = rot + ((size_t)pos * 64 + i0) * 2; T0[am] = *(const GAS f32x4*)tp; T1[am] = *(const GAS f32x4*)(tp + 4); }
        } else {
#pragma unroll
            for (int am = 0; am < 8; ++am) { T0[am] = (f32x4){1.f, 0.f, 1.f, 0.f}; T1[am] = T0[am]; }
        }
#pragma unroll
        for (int ai = 0; ai < 2; ++ai)
#pragma unroll
            for (int m = 0; m < 4; ++m) { const int row = row0 + ai * 128 + m * 16, pos = row & (SEQ - 1);
                bf16* rowp = O + (size_t)row * NPROJ + col0;
                const f32x4 t0 = T0[ai * 4 + m], t1 = T1[ai * 4 + m];
#pragma unroll
                for (int bj = 0; bj < 2; ++bj) { f32x4 v0 = acc[ai][bj][m][0], v1 = acc[ai][bj][m][1];
                    if (kind == 0) { v0 = v0 * attn_body::C2; v1 = v1 * attn_body::C2; }
                    else if (kind == 3 || kind == 4) {
                        f32x4 w0, w1;
                        w0.x = v0.x * t0.x - v0.y * t0.y; w0.y = v0.x * t0.y + v0.y * t0.x; w0.z = v0.z * t0.z - v0.w * t0.w; w0.w = v0.z * t0.w + v0.w * t0.z;
                        w1.x = v1.x * t1.x - v1.y * t1.y; w1.y = v1.x * t1.y + v1.y * t1.x; w1.z = v1.z * t1.z - v1.w * t1.w; w1.w = v1.z * t1.w + v1.w * t1.z;
                        v0 = w0; v1 = w1;
                        if (kind == 4) { const float sc = 0.08838834764831845f * __builtin_amdgcn_exp2f(lg2h[bj] * (float)(64 - (pos & 63))); v0 = v0 * sc; v1 = v1 * sc; }
                    } else if (kind == 6) {
                        v0.x = silu_f(v0.x); v0.y = silu_f(v0.y); v0.z = silu_f(v0.z); v0.w = silu_f(v0.w); v1.x = silu_f(v1.x); v1.y = silu_f(v1.y); v1.z = silu_f(v1.z); v1.w = silu_f(v1.w);
                    }
                    if (kind == 1) { const float q2 = ((v0.x * v0.x + v0.y * v0.y) + (v0.z * v0.z + v0.w * v0.w)) + ((v1.x * v1.x + v1.y * v1.y) + (v1.z * v1.z + v1.w * v1.w)); kmx[bj] = fmaxf(kmx[bj], q2); }
                    v4u w; w.x = pg8::cvt_pk_bf16(v0[0], v0[1]); w.y = pg8::cvt_pk_bf16(v0[2], v0[3]); w.z = pg8::cvt_pk_bf16(v1[0], v1[1]); w.w = pg8::cvt_pk_bf16(v1[2], v1[3]);
#ifdef MK_EPIPROBE
                    if (SKIP) asm volatile("" :: "v"(w.x), "v"(w.y), "v"(w.z), "v"(w.w)); else
#endif
                    *(GAS v4u*)(rowp + bj * 128) = w; } }
        if (kind == 1) {
#pragma unroll
            for (int bj = 0; bj < 2; ++bj) { float m_ = kmx[bj]; m_ = fmaxf(m_, shx_f(m_, 1)); m_ = fmaxf(m_, shx_f(m_, 2)); m_ = fmaxf(m_, shx_f(m_, 4)); m_ = fmaxf(m_, shx_f(m_, 8));
                if (fr == 0) { const int b_ = u.pm >> 4, h_ = 4 * (u.pn & 1) + 2 * bj + (wc >> 1), c_ = 4 * (wc & 1) + fq;
                    atomicMax(kb + (b_ * FH + h_) * 8 + c_, __float_as_uint(m_ * 1.02f)); } } }
    }
};

typedef EpiProjT<false> EpiProj;
constexpr int RP = 272;
constexpr int RT_TILE = 64 * RP, RT_BUF = 3 * RT_TILE;
constexpr int RL_OUTP = 2 * RT_BUF, RL_OUTP_W = 32 * 80, RL_SSP = RL_OUTP + 8 * RL_OUTP_W;
static_assert(RL_SSP + 2 * 64 * 4 * 4 <= RING_BYTES, "retention LDS map");
__device__ __forceinline__ int crow16(int r, int hi) { return (r & 3) + 8 * (r >> 2) + 4 * hi; }
typedef short v4i16r __attribute__((ext_vector_type(4)));
__device__ __forceinline__ s16x4 rtr(const LAS unsigned char* p) { return __builtin_bit_cast(s16x4, __builtin_amdgcn_ds_read_tr16_b64_v4i16((LAS v4i16r*)p)); }
__device__ __forceinline__ bf16x8 tr_frag(const LAS unsigned char* img, int ra, int rb, int colb, int lane) {
    const int q = (lane & 15) >> 2, cb = (colb + 16 * ((lane >> 4) & 1) + 4 * (lane & 3)) * 2;
    const s16x4 lo = rtr(img + (ra + q) * RP + cb), hi = rtr(img + (rb + q) * RP + cb);
    return (bf16x8){lo[0], lo[1], lo[2], lo[3], hi[0], hi[1], hi[2], hi[3]};
}
__device__ __forceinline__ bf16x8 pack8(const f32x16& x, int b) {
    v4u w; w.x = pg8::cvt_pk_bf16(x[b], x[b + 1]); w.y = pg8::cvt_pk_bf16(x[b + 2], x[b + 3]); w.z = pg8::cvt_pk_bf16(x[b + 4], x[b + 5]); w.w = pg8::cvt_pk_bf16(x[b + 6], x[b + 7]);
    return __builtin_bit_cast(bf16x8, w);
}
__device__ __forceinline__ bf16x8 ld2x64(const LAS unsigned char* p) {
    const v2u a = *(const LAS v2u*)p, b = *(const LAS v2u*)(p + 16); const v4u w = {a.x, a.y, b.x, b.y}; return __builtin_bit_cast(bf16x8, w);
}
#define RBAR() asm volatile("s_waitcnt lgkmcnt(0)\n\ts_barrier" ::: "memory")
__device__ __forceinline__ void ret_passA(Frame& F) {
    const bf16* PROJ = (const bf16*)(F.ws + WS_PROJ); float* SEG = (float*)(F.ws + WS_SEG);
    const int tid = F.tid, lane = F.lane, r32 = lane & 31, hi = lane >> 5, es = F.wave & 3, dh = F.wave >> 2;
    const int sl = tid >> 3, c16 = (tid & 7) * 16;
    for (int u = F.vcu; u < 256; u += F.G) {
        const int b = u >> 5, hr = (u >> 3) & 3, seg = u & 7; const size_t row0 = (size_t)b * SEQ + seg * 512;
        if (seg == 7) continue;
        const float g64 = __builtin_amdgcn_exp2f(ret_lg2(hr) * 64.f);
        f32x16 acc[2]; acc[0] = f32x16{}; acc[1] = f32x16{};
        const bf16* src = PROJ + (row0 + sl) * NPROJ + hr * 128 + c16;
        v4u k0 = *(const GAS v4u*)(src + PRK), k1 = *(const GAS v4u*)(src + PRK + 8), v0 = *(const GAS v4u*)(src + PRV), v1 = *(const GAS v4u*)(src + PRV + 8);
        __syncthreads();
        { LAS unsigned char* d = F.lds + RT_TILE + sl * RP + c16 * 2; *(LAS v4u*)d = k0; *(LAS v4u*)(d + 16) = k1; *(LAS v4u*)(d + RT_TILE) = v0; *(LAS v4u*)(d + RT_TILE + 16) = v1; }
        src += (size_t)64 * NPROJ;
        k0 = *(const GAS v4u*)(src + PRK); k1 = *(const GAS v4u*)(src + PRK + 8); v0 = *(const GAS v4u*)(src + PRV); v1 = *(const GAS v4u*)(src + PRV + 8);
        RBAR();
        for (int ch = 0; ch < 8; ++ch) {
            int hi_ = hi, lane_ = lane; asm volatile("" : "+v"(hi_), "+v"(lane_));
            const LAS unsigned char* kI = F.lds + (ch & 1) * RT_BUF + RT_TILE; const LAS unsigned char* vI = kI + RT_TILE;
            if (ch > 0) { acc[0] = acc[0] * g64; acc[1] = acc[1] * g64; }
#pragma unroll
            for (int ks = 0; ks < 4; ++ks) { const bf16x8 bv = tr_frag(vI, 16 * ks + 8 * hi_, 16 * ks + 8 * hi_ + 4, 32 * es, lane_);
#pragma unroll
                for (int dt = 0; dt < 2; ++dt) { const bf16x8 av = tr_frag(kI, 16 * ks + 8 * hi_, 16 * ks + 8 * hi_ + 4, 64 * dh + 32 * dt, lane_);
                    acc[dt] = __builtin_amdgcn_mfma_f32_32x32x16_bf16(av, bv, acc[dt], 0, 0, 0); } }
            if (ch + 1 < 8) { LAS unsigned char* d = F.lds + ((ch + 1) & 1) * RT_BUF + RT_TILE + sl * RP + c16 * 2; *(LAS v4u*)d = k0; *(LAS v4u*)(d + 16) = k1; *(LAS v4u*)(d + RT_TILE) = v0; *(LAS v4u*)(d + RT_TILE + 16) = v1; }
            if (ch + 2 < 8) { src += (size_t)64 * NPROJ; k0 = *(const GAS v4u*)(src + PRK); k1 = *(const GAS v4u*)(src + PRK + 8); v0 = *(const GAS v4u*)(src + PRV); v1 = *(const GAS v4u*)(src + PRV + 8); }
            RBAR();
        }
        float* so = SEG + (size_t)u * 128 * 128;
#pragma unroll
        for (int dt = 0; dt < 2; ++dt)
#pragma unroll
            for (int r = 0; r < 16; ++r) so[(64 * dh + 32 * dt + crow16(r, hi)) * 128 + 32 * es + r32] = acc[dt][r];
    }
    __syncthreads();
}
constexpr int RB_Q = 0, RB_V = RT_TILE, RB_K = 2 * RT_TILE, RB_SF = 4 * RT_TILE, RB_P = RB_SF + 32768, RB_PP = 144, RB_PATCH = RB_P + 2 * 32 * RB_PP, RB_SSP = RB_PATCH + 8 * RL_OUTP_W;
static_assert((AUX_U2 + 64) * 4 <= AUX_BYTES && AUX_TOK + AUX_MAXU * 256 <= AUX_U2, "AUX map");
static_assert(RB_SSP + 64 * 4 * 4 <= MISC_OFF, "retention pass B LDS map");
__device__ __forceinline__ void ret_passB_unit(Frame& F, const int u) {
    const bf16* PROJ = (const bf16*)(F.ws + WS_PROJ); const float* SEG = (const float*)(F.ws + WS_SEG); bf16* MIX = (bf16*)(F.ws + WS_HN);
    const int tid = F.tid, lane = F.lane, r32 = lane & 31, hi = lane >> 5, es = F.wave & 3, qh = F.wave >> 2;
    const int sl = tid >> 3, c16 = (tid & 7) * 16, jc = lane & 15, g4 = lane >> 4;
    LAS unsigned char* const qI = F.lds + RB_Q; LAS unsigned char* const vI = F.lds + RB_V; LAS unsigned char* const sfI = F.lds + RB_SF + es * 8192; LAS unsigned char* const pI = F.lds + RB_P + qh * (32 * RB_PP);
    LAS float* const ssp = (LAS float*)(F.lds + RB_SSP);
    const int b = u >> 5, hr = (u >> 3) & 3, seg = u & 7; const size_t row0 = (size_t)b * SEQ + seg * 512;
    const float lg2 = ret_lg2(hr), g64 = __builtin_amdgcn_exp2f(lg2 * 64.f), g512 = __builtin_amdgcn_exp2f(lg2 * 512.f);
    const bf16* src = PROJ + (row0 + sl) * NPROJ + hr * 128 + c16;
    v4u q0 = *(const GAS v4u*)(src + PRQ), q1 = *(const GAS v4u*)(src + PRQ + 8), k0 = *(const GAS v4u*)(src + PRK), k1 = *(const GAS v4u*)(src + PRK + 8),
        v0 = *(const GAS v4u*)(src + PRV), v1 = *(const GAS v4u*)(src + PRV + 8);
    f32x16 S0 = f32x16{}, S1 = f32x16{};
    for (int g = 0; g < seg; ++g) { const float* sp = SEG + (size_t)(u - seg + g) * 128 * 128 + (size_t)(64 * qh) * 128 + 32 * es + r32;
#pragma unroll
        for (int r = 0; r < 16; ++r) { S0[r] = S0[r] * g512 + sp[crow16(r, hi) * 128]; S1[r] = S1[r] * g512 + sp[(32 + crow16(r, hi)) * 128]; } }
    const float gj = __builtin_amdgcn_exp2f(lg2 * (float)(32 * qh + r32));
    const int l0 = 16 * es + 4 * g4; int jj[2]; float fa[2], fb[2];
#pragma unroll
    for (int jt = 0; jt < 2; ++jt) { jj[jt] = 32 * qh + 16 * jt + jc; fa[jt] = __builtin_amdgcn_exp2f(lg2 * (float)(jj[jt] - 64)); fb[jt] = __builtin_amdgcn_exp2f(lg2 * (float)(2 * l0 - jj[jt] - 64)); }
    float gr[4]; gr[0] = 1.f; gr[1] = __builtin_amdgcn_exp2f(lg2 * 2.f); gr[2] = gr[1] * gr[1]; gr[3] = gr[2] * gr[1];
    const int cbl = (16 * ((lane >> 4) & 1) + 4 * (lane & 3)) * 2, tq = (lane & 15) >> 2;
    const int oTN = (8 * hi + tq) * RP + cbl;
    const int oQ2 = (32 * qh + r32) * RP + 8 * hi;
    const int oKs = (16 * es + jc) * RP + 16 * g4, oQs = (32 * qh + jc) * RP + 16 * g4;
#define TRF(img, off, rowa, rowb, colb) ({ const s16x4 lo_ = rtr((img) + (off) + (rowa) * RP + (colb) * 2), hi_v = rtr((img) + (off) + (rowb) * RP + (colb) * 2); \
        (bf16x8){lo_[0], lo_[1], lo_[2], lo_[3], hi_v[0], hi_v[1], hi_v[2], hi_v[3]}; })
#define ST16(img, a_, b_) do { LAS unsigned char* d_ = (img) + sl * RP + c16 * 2; *(LAS v4u*)d_ = (a_); *(LAS v4u*)(d_ + 16) = (b_); } while (0)
#define SF_WRITE() do { *(LAS v4u*)(sfI + ((4 * qh + 0) * 64 + lane) * 16) = __builtin_bit_cast(v4u, pack8(S0, 0)); *(LAS v4u*)(sfI + ((4 * qh + 1) * 64 + lane) * 16) = __builtin_bit_cast(v4u, pack8(S0, 8)); \
        *(LAS v4u*)(sfI + ((4 * qh + 2) * 64 + lane) * 16) = __builtin_bit_cast(v4u, pack8(S1, 0)); *(LAS v4u*)(sfI + ((4 * qh + 3) * 64 + lane) * 16) = __builtin_bit_cast(v4u, pack8(S1, 8)); } while (0)
    __syncthreads();
    ST16(qI, q0, q1); ST16(F.lds + RB_K, k0, k1); SF_WRITE();
    f32x16 o = f32x16{}; v2u gt[4]; gt[0] = (v2u){0u, 0u}; gt[1] = gt[0]; gt[2] = gt[0]; gt[3] = gt[0]; size_t orow = 0; const int ocol = hr * 128 + 32 * es;
    for (int ch = 0; ch <= 8; ++ch) {
        RBAR();
        if (ch > 0) {
            const f32x4 p4 = *(const LAS f32x4*)(ssp + (32 * qh + r32) * 4);
            const float rstd = __builtin_amdgcn_rsqf(((p4.x + p4.y) + (p4.z + p4.w)) * (1.f / 128.f) + eps_s()) * MIX_SCALE;
#if MK_MIX8
            unsigned w8[4];
#pragma unroll
            for (int g = 0; g < 4; ++g) { const v2u gv = gt[g];
                w8[g] = pg8::pk4_fp8(o[4 * g] * rstd * bf2f(gv.x & 0xffffu), o[4 * g + 1] * rstd * bf2f(gv.x >> 16), o[4 * g + 2] * rstd * bf2f(gv.y & 0xffffu), o[4 * g + 3] * rstd * bf2f(gv.y >> 16)); }
            { auto r0 = __builtin_amdgcn_permlane32_swap(w8[0], w8[2], false, false); w8[0] = r0[0]; w8[2] = r0[1];
              auto r1 = __builtin_amdgcn_permlane32_swap(w8[1], w8[3], false, false); w8[1] = r1[0]; w8[3] = r1[1]; }
            *(GAS v4u*)((unsigned char*)MIX + orow * DM + 512 + ocol + 16 * hi) = (v4u){w8[0], w8[2], w8[1], w8[3]};
#else
            v2u w[4];
#pragma unroll
            for (int g = 0; g < 4; ++g) { const v2u gv = gt[g];
                w[g].x = pg8::cvt_pk_bf16(o[4 * g] * rstd * bf2f(gv.x & 0xffffu), o[4 * g + 1] * rstd * bf2f(gv.x >> 16));
                w[g].y = pg8::cvt_pk_bf16(o[4 * g + 2] * rstd * bf2f(gv.y & 0xffffu), o[4 * g + 3] * rstd * bf2f(gv.y >> 16)); }
            { auto r0 = __builtin_amdgcn_permlane32_swap(w[0].x, w[2].x, false, false); w[0].x = r0[0]; w[2].x = r0[1];
              auto r1 = __builtin_amdgcn_permlane32_swap(w[0].y, w[2].y, false, false); w[0].y = r1[0]; w[2].y = r1[1];
              auto r2 = __builtin_amdgcn_permlane32_swap(w[1].x, w[3].x, false, false); w[1].x = r2[0]; w[3].x = r2[1];
              auto r3 = __builtin_amdgcn_permlane32_swap(w[1].y, w[3].y, false, false); w[1].y = r3[0]; w[3].y = r3[1]; }
            bf16* op = MIX + orow * DM + 512 + ocol + 16 * hi;
            *(GAS v4u*)op = (v4u){w[0].x, w[0].y, w[2].x, w[2].y};
            *(GAS v4u*)(op + 8) = (v4u){w[1].x, w[1].y, w[3].x, w[3].y};
#endif
        }
        if (ch == 8) break;
        const LAS unsigned char* kI = F.lds + RB_K + (ch & 1) * RT_TILE;
        ST16(vI, v0, v1);
        if (ch + 1 < 8) { src += (size_t)64 * NPROJ; q0 = *(const GAS v4u*)(src + PRQ); q1 = *(const GAS v4u*)(src + PRQ + 8); k0 = *(const GAS v4u*)(src + PRK); k1 = *(const GAS v4u*)(src + PRK + 8);
            v0 = *(const GAS v4u*)(src + PRV); v1 = *(const GAS v4u*)(src + PRV + 8); }
        orow = row0 + 64 * ch + 32 * qh + r32;
#pragma unroll
        for (int g = 0; g < 4; ++g) gt[g] = *(const GAS v2u*)(PROJ + orow * NPROJ + PRG + ocol + 8 * g + 4 * hi);
        {
            f32x4 sc[2]; sc[0] = (f32x4){0.f, 0.f, 0.f, 0.f}; sc[1] = sc[0];
#pragma unroll
            for (int ks = 0; ks < 4; ++ks) { const bf16x8 kf = *(const LAS bf16x8*)(kI + oKs + 64 * ks);
#pragma unroll
                for (int jt = 0; jt < 2; ++jt) { const bf16x8 qf = *(const LAS bf16x8*)(qI + oQs + 16 * jt * RP + 64 * ks);
                    sc[jt] = __builtin_amdgcn_mfma_f32_16x16x32_bf16(kf, qf, sc[jt], 0, 0, 0); } }
#pragma unroll
            for (int jt = 0; jt < 2; ++jt) { float w_[4];
#pragma unroll
                for (int r = 0; r < 4; ++r) w_[r] = sc[jt][r] * ((l0 + r <= jj[jt]) ? fa[jt] : fb[jt] * gr[r]);
                *(LAS v2u*)(pI + (16 * jt + jc) * RB_PP + l0 * 2) = (v2u){pg8::cvt_pk_bf16(w_[0], w_[1]), pg8::cvt_pk_bf16(w_[2], w_[3])}; }
        }
        o = f32x16{};
#pragma unroll
        for (int dt = 0; dt < 4; ++dt)
#pragma unroll
            for (int s2 = 0; s2 < 2; ++s2) { const bf16x8 qf = ld2x64(qI + oQ2 + (32 * dt + 16 * s2) * 2); const bf16x8 sf = *(const LAS bf16x8*)(sfI + ((2 * dt + s2) * 64 + lane) * 16);
                o = __builtin_amdgcn_mfma_f32_32x32x16_bf16(sf, qf, o, 0, 0, 0); }
#pragma unroll
        for (int r = 0; r < 16; ++r) o[r] *= gj;
        RBAR();
#pragma unroll
        for (int ks = 0; ks < 4; ++ks) { const bf16x8 pf = *(const LAS bf16x8*)(pI + r32 * RB_PP + 32 * ks + 16 * hi); const bf16x8 vf = TRF(vI, oTN, 16 * ks, 16 * ks + 4, 32 * es);
            o = __builtin_amdgcn_mfma_f32_32x32x16_bf16(vf, pf, o, 0, 0, 0); }
        { float t = 0.f;
#pragma unroll
          for (int r = 0; r < 16; ++r) t += o[r] * o[r];
          const auto sw = __builtin_amdgcn_permlane32_swap(__float_as_uint(t), __float_as_uint(t), false, false);
          if (hi == 0) ssp[(32 * qh + r32) * 4 + es] = __uint_as_float(sw[0]) + __uint_as_float(sw[1]); }
        S0 = S0 * g64; S1 = S1 * g64;
#pragma unroll
        for (int ks = 0; ks < 4; ++ks) { const bf16x8 bv = TRF(vI, oTN, 16 * ks, 16 * ks + 4, 32 * es);
            const bf16x8 a0 = TRF(kI, oTN, 16 * ks, 16 * ks + 4, 64 * qh), a1 = TRF(kI, oTN, 16 * ks, 16 * ks + 4, 64 * qh + 32);
            S0 = __builtin_amdgcn_mfma_f32_32x32x16_bf16(a0, bv, S0, 0, 0, 0); S1 = __builtin_amdgcn_mfma_f32_32x32x16_bf16(a1, bv, S1, 0, 0, 0); }
        SF_WRITE();
        if (ch + 1 < 8) { ST16(qI, q0, q1); ST16(F.lds + RB_K + ((ch + 1) & 1) * RT_TILE, k0, k1); }
    }
#undef TRF
#undef ST16
#undef SF_WRITE
    __syncthreads();
}
#undef RBAR
static_assert(IT_DENSE % CVT_UNITS == 0, "dense items per conversion unit");
__device__ __forceinline__ void pc_phase(Frame& F, int layer, int qsel, const float* w_in, const float* w_out, const float* w_eg, const float* w_eu, const float* w_ed) {
    const bf16* P = (const bf16*)(F.ws + WS_PROJ); const float* CL = (const float*)(F.ws + WS_CL);
    const unsigned* KBw = (const unsigned*)(F.ctl + CW_KB + layer * 512);
    LAS int* qslot = (LAS int*)(F.lds + attn_body::LDS_CLTMP + 64);
    int qnext = 0; bool have_next = false;
    bool first = true;
    for (;;) {
        int qidx;
        if (first) { first = false; qidx = (int)blockIdx.x; asm volatile("" : "+s"(qidx)); __syncthreads(); }
        else {
            __syncthreads();
            if (F.wave == 0 && lane_id() == 0) *qslot = (have_next ? qnext : (int)__hip_atomic_fetch_add(F.ctl + CW_Q + qsel, 1u, RLX_AGENT)) + F.G;
            __syncthreads();
            have_next = false;
            qidx = __builtin_amdgcn_readfirstlane(*qslot); }
        if (qidx >= CVT_UNITS + 1024 + 256) break;
#ifdef MK_PCPROBE
        if (qsel >= 2) { const int cat = qidx < CVT_UNITS ? 1 : qidx < 256 + CVT_UNITS ? 4 : 2; if (!((MK_PCPROBE) & cat)) continue; }
#endif
        if (qidx >= CVT_UNITS && qidx < CVT_UNITS + 256) { const int rq = qidx - CVT_UNITS;
            { int t_ = F.wave * 64 + lane_id(); asm volatile("" : "+v"(t_)); F.tid = t_; F.lane = t_ & 63; }
            ret_passB_unit(F, (rq & 31) * 8 + 7 - (rq >> 5));
            continue;
        }
        if (qidx < CVT_UNITS) {
            { int t_ = F.wave * 64 + lane_id(); asm volatile("" : "+v"(t_)); F.tid = t_; F.lane = t_ & 63; }
            LAS float* scr = (LAS float*)(F.lds) + F.wave * (64 * 65);
#if MK_BARWORK
            if (layer + 1 < DEPTH) for (int j = F.wave; j < IT_DENSE / CVT_UNITS; j += NWAVES) p0_do_item(F, layer + 1, qidx * (IT_DENSE / CVT_UNITS) + j, w_in, w_out, nullptr, nullptr, nullptr, scr);
            while (cvt_pull_chunk(F, layer, qslot + 1, w_eg, w_eu, w_ed)) {}
#else
            for (int j = F.wave; j < CVT_PER_UNIT; j += NWAVES) p0_do_item(F, layer, IT_DENSE + qidx * CVT_PER_UNIT + j, nullptr, nullptr, w_eg, w_eu, w_ed, scr);
            if (layer + 1 < DEPTH) for (int j = F.wave; j < IT_DENSE / CVT_UNITS; j += NWAVES) p0_do_item(F, layer + 1, qidx * (IT_DENSE / CVT_UNITS) + j, w_in, w_out, nullptr, nullptr, nullptr, scr);
#endif
            continue;
        }
        const int idx = qidx - 256 - CVT_UNITS;
        {
            const int qb = 15 - (idx >> 6), bh = idx & 63;
            LAS f32x4* cl4 = (LAS f32x4*)(F.lds + attn_body::LDS_CL); const f32x4* src4 = (const f32x4*)(CL + (size_t)bh * SEQ);
            for (int i = F.tid; i < (qb + 1) * 64; i += NTHREADS) cl4[i] = src4[i];
            float kb2 = 0.f;
#pragma unroll
            for (int c = 0; c < 8; ++c) kb2 += __uint_as_float(KBw[bh * 8 + c]);
            const float Kb = __builtin_amdgcn_sqrtf(kb2) * 1.0001f;
            __syncthreads();
            attn_body::attn_unit<8>(bh >> 3, bh & 7, qb, (const attn_body::hb16*)(P + PQ), (const attn_body::hb16*)(P + PK), (const attn_body::hb16*)(P + PV), (attn_body::hb16*)(F.ws + WS_HN), (char*)F.lds, Kb, F.wave, F.ctl + CW_Q + qsel, qnext);
            have_next = true;
        }
    }
}
__device__ __forceinline__ void cl_tables(Frame& F) {
    const bool paired = (F.G == 256);
    const int first = paired ? (((F.vcu & 7) == 7) ? 2 * (F.vcu >> 3) : 64) : F.vcu, n = paired ? 2 : 1;
    for (int t = 0; t < n; ++t) { const int bh = first + t;
        if (bh < 64) {
            attn_body::fox_cumsum((const float*)(F.ws + WS_LOGF), bh >> 3, bh & 7, (char*)F.lds, F.wave);
            const LAS f32x4* cl4 = (const LAS f32x4*)(F.lds + attn_body::LDS_CL); f32x4* dst4 = (f32x4*)((float*)(F.ws + WS_CL) + (size_t)bh * SEQ);
            for (int i = F.tid; i < SEQ / 4; i += NTHREADS) dst4[i] = cl4[i];
            __syncthreads();
        } }
}

struct EpiRes {
    static constexpr bool PERM = true;
    int wave; const float* basef; bf16* xb; float* rowss;
    __device__ __forceinline__ void operator()(const f32x4 (&acc)[2][2][4][2], const pg8::Unit& u, int) const {
        int t_ = wave * 64 + lane_id(); asm volatile("" : "+v"(t_));
        const int fr = t_ & 15, fq = (t_ >> 4) & 3, wid_ = __builtin_amdgcn_readfirstlane(t_ >> 6), wr = wid_ >> 2, wc = wid_ & 3;
        const int col0 = u.pn * 256 + wc * 32 + 8 * fq;
        const bool f32base = basef != nullptr;
        const float ws_ = MK_MIX8 ? W8_INV / MIX_SCALE : 1.f;
#pragma unroll
        for (int ai = 0; ai < 2; ++ai) {
            const size_t off0 = (size_t)(u.pm * 256 + ai * 128 + wr * 64 + fr) * DM + col0;
            f32x4 b[4][2][2];
            if (f32base) {
#pragma unroll
                for (int m = 0; m < 4; ++m)
#pragma unroll
                    for (int bj = 0; bj < 2; ++bj) { const float* p = basef + off0 + (size_t)m * 16 * DM + bj * 128; b[m][bj][0] = *(const GAS f32x4*)p; b[m][bj][1] = *(const GAS f32x4*)(p + 4); }
            } else {
                v4u q[4][2];
#pragma unroll
                for (int m = 0; m < 4; ++m)
#pragma unroll
                    for (int bj = 0; bj < 2; ++bj) q[m][bj] = *(const GAS v4u*)(xb + off0 + (size_t)m * 16 * DM + bj * 128);
#pragma unroll
                for (int m = 0; m < 4; ++m)
#pragma unroll
                    for (int bj = 0; bj < 2; ++bj) { const v4u w = q[m][bj];
                        b[m][bj][0] = (f32x4){bf2f(w.x & 0xffffu), bf2f(w.x >> 16), bf2f(w.y & 0xffffu), bf2f(w.y >> 16)}; b[m][bj][1] = (f32x4){bf2f(w.z & 0xffffu), bf2f(w.z >> 16), bf2f(w.w & 0xffffu), bf2f(w.w >> 16)}; }
            }
#pragma unroll
            for (int m = 0; m < 4; ++m) { const int r = u.pm * 256 + ai * 128 + wr * 64 + m * 16 + fr; float ss = 0.f;
#pragma unroll
                for (int bj = 0; bj < 2; ++bj) {
                    const f32x4 o0 = b[m][bj][0] + acc[ai][bj][m][0] * ws_, o1 = b[m][bj][1] + acc[ai][bj][m][1] * ws_;
                    *(GAS v4u*)(xb + off0 + (size_t)m * 16 * DM + bj * 128) = (v4u){pg8::cvt_pk_bf16(o0.x, o0.y), pg8::cvt_pk_bf16(o0.z, o0.w), pg8::cvt_pk_bf16(o1.x, o1.y), pg8::cvt_pk_bf16(o1.z, o1.w)};
                    ss += ((o0.x * o0.x + o0.y * o0.y) + (o0.z * o0.z + o0.w * o0.w)) + ((o1.x * o1.x + o1.y * o1.y) + (o1.z * o1.z + o1.w * o1.w)); }
                ss += shx_f(ss, 16); ss += shx_f(ss, 32);
                if (fq == 0) rowss[(size_t)r * 16 + u.pn * 4 + wc] = ss; }
            asm volatile("" ::: "memory");
        }
    }
};

constexpr int PF_FR = 0, PF_LG = 98304, PF_NW = 122880, PF_HIST = 126976, PF_BASE = 127104;
__device__ __forceinline__ void pf_phase(Frame& F, int layer, const float* brg, const float* bre, const float* normw) {
    const int tid = F.tid, lane = F.lane, wave = F.wave;
    const float* rowss = (const float*)(F.ws + WS_ROWSS);
    LAS v4u* fr = (LAS v4u*)(F.lds + PF_FR); LAS float* lg = (LAS float*)(F.lds + PF_LG) + wave * (16 * 48); LAS float* nwl = (LAS float*)(F.lds + PF_NW);
    LAS int* hist = (LAS int*)(F.lds + PF_HIST); LAS int* basel = (LAS int*)(F.lds + PF_BASE);
    { const v4u* rfr = (const v4u*)(F.ws + WS_RFR) + (size_t)layer * RFR_N;
      for (int q = tid; q < RFR_N; q += NTHREADS) fr[q] = rfr[q]; }
    for (int q = tid; q < DM; q += NTHREADS) nwl[q] = normw[q];
    if (tid < 32) hist[tid] = 0;
    __syncthreads();
    unsigned char* HN8 = F.ws + WS_HN; int4* RT = (int4*)(F.ws + WS_RT); int* TOK = (int*)(F.ws + WS_TOK); float* WL = (float*)(F.ws + WS_WL);
    const int NRG = M / 16, per = F.G * NWAVES, iters = (NRG + per - 1) / per;
    for (int it = 0; it < iters; ++it) {
        const int rg = it * per + F.vcu * NWAVES + wave; const bool valid = rg < NRG;
        int e1 = 0, e2 = 0, lr1 = 0, lr2 = 0; float w1 = 0.f, w2 = 0.f;
        if (valid) {
            const int row = rg * 16 + (lane & 15), g = lane >> 4;
            float ss = 0.f;
#pragma unroll
            for (int j = 0; j < 4; ++j) { const f32x4 p = *(const GAS f32x4*)(rowss + (size_t)row * 16 + 4 * j); ss += (p.x + p.y) + (p.z + p.w); }
            const float rstd = __builtin_amdgcn_rsqf(ss * (1.f / DM) + eps_s());
            f32x4 acc[3]; acc[0] = (f32x4){0.f, 0.f, 0.f, 0.f}; acc[1] = acc[0]; acc[2] = acc[0];
            const bf16* xr = (const bf16*)(F.ws + WS_XB) + (size_t)row * DM + 8 * g; unsigned char* hr = HN8 + ((size_t)row * DM + 8 * g) * XSZ;
            v4u xqa[32];
#pragma unroll
            for (int s = 0; s < 32; ++s) xqa[s] = *(const GAS v4u*)(xr + 32 * s);
#pragma unroll
            for (int s = 0; s < 32; ++s) {
                const v4u xq = xqa[s];
                const f32x4 xa = {bf2f(xq.x & 0xffffu), bf2f(xq.x >> 16), bf2f(xq.y & 0xffffu), bf2f(xq.y >> 16)}, xb = {bf2f(xq.z & 0xffffu), bf2f(xq.z >> 16), bf2f(xq.w & 0xffffu), bf2f(xq.w >> 16)};
                const f32x4 na = *(const LAS f32x4*)(nwl + 32 * s + 8 * g), nb = *(const LAS f32x4*)(nwl + 32 * s + 8 * g + 4);
                const f32x4 ha = xa * rstd * na, hb = xb * rstd * nb;
                const v4u hw = {pk2(ha.x, ha.y), pk2(ha.z, ha.w), pk2(hb.x, hb.y), pk2(hb.z, hb.w)};
                if (MK_FP8) *(GAS v2u*)(hr + 32 * s) = (v2u){pg8::pk4_fp8(ha.x, ha.y, ha.z, ha.w), pg8::pk4_fp8(hb.x, hb.y, hb.z, hb.w)};
                else *(GAS v4u*)(hr + 64 * s) = hw;
                const bf16x8 af = __builtin_bit_cast(bf16x8, hw);
#pragma unroll
                for (int nt = 0; nt < 3; ++nt) { const bf16x8 bf = __builtin_bit_cast(bf16x8, fr[(s * 3 + nt) * 64 + lane]);
                    acc[nt] = __builtin_amdgcn_mfma_f32_16x16x32_bf16(af, bf, acc[nt], 0, 0, 0); }
            }
#pragma unroll
            for (int nt = 0; nt < 3; ++nt)
#pragma unroll
                for (int r = 0; r < 4; ++r) lg[(4 * g + r) * 48 + 16 * nt + (lane & 15)] = acc[nt][r];
            LDS_WAIT(); asm volatile("" ::: "memory");
            if (lane < 16) {
                const LAS float* L = lg + lane * 48;
                float gl[4]; int gi = 0;
#pragma unroll
                for (int j = 0; j < 4; ++j) gl[j] = L[j] + brg[j];
#pragma unroll
                for (int j = 1; j < 4; ++j) if (gl[j] > gl[gi]) gi = j;
                float gs = 0.f;
#pragma unroll
                for (int j = 0; j < 4; ++j) gs += __expf(gl[j] - gl[gi]);
                const float gw_ = 1.f / gs;
                float el[8];
#pragma unroll
                for (int j = 0; j < 8; ++j) el[j] = L[NG + 8 * gi + j] + bre[8 * gi + j];
                int i1 = 0;
#pragma unroll
                for (int j = 1; j < 8; ++j) if (el[j] > el[i1]) i1 = j;
                int i2 = -1;
#pragma unroll
                for (int j = 0; j < 8; ++j) if (j != i1 && (i2 < 0 || el[j] > el[i2])) i2 = j;
                const float p1 = 1.f / (1.f + __expf(el[i2] - el[i1]));
                w1 = gw_ * p1; w2 = gw_ * (1.f - p1);
                e1 = 8 * gi + i1; e2 = 8 * gi + i2;
                lr1 = atomicAdd((int*)(hist + e1), 1); lr2 = atomicAdd((int*)(hist + e2), 1);
            }
        }
        __syncthreads();
        if (tid < 32) { const int c = hist[tid]; basel[tid] = c ? (int)__hip_atomic_fetch_add(F.ctl + CW_CNT + layer * 32 + tid, (unsigned)c, RLX_AGENT) : 0; hist[tid] = 0; }
        __syncthreads();
        if (valid && lane < 16) { const int row = rg * 16 + lane; const int r1 = basel[e1] + lr1, r2 = basel[e2] + lr2;
            RT[row] = make_int4(e1, r1, e2, r2);
            TOK[(size_t)e1 * CAP + r1] = row; WL[(size_t)e1 * CAP + r1] = w1; TOK[(size_t)e2 * CAP + r2] = row; WL[(size_t)e2 * CAP + r2] = w2; }
        __syncthreads();
    }
}

struct ExpertOrder1 {
    static constexpr bool GATHER = true;
    const char* A; const char* Bt; LAS int* aux; int G, vcu;
    __device__ __forceinline__ bool next(int i, pg8::Unit& u) const {
        if (i >= 16) return false;
        const int e = __builtin_amdgcn_readfirstlane(aux[AUX_U + 2 * i]); if (e < 0) return false;
        const int L = i * G + vcu; u.pm = L >> 2; u.pn = L & 3; u.e = e; u.ml = __builtin_amdgcn_readfirstlane(aux[AUX_U + 2 * i + 1]); return true; }
    __device__ __forceinline__ const char* a_base(const pg8::Unit&) const { return A; }
    __device__ __forceinline__ const char* b_base(const pg8::Unit& u) const { return Bt + ((size_t)u.e * 1024 + u.pn * 256) * 1024 * XSZ; }
    __device__ __forceinline__ unsigned a_row_off(int ui, int r) const { return (unsigned)aux[AUX_TOK + ui * 256 + r] * (unsigned)(DM * XSZ); }
    __device__ __forceinline__ void a_ready(const pg8::Unit&, int) const {}
};
struct ExpertOrder2 {
    static constexpr bool GATHER = false;
    const char* A; const char* Bt; LAS int* aux; int G, vcu; const unsigned* rdy; unsigned* tmo;
    __device__ __forceinline__ bool next(int i, pg8::Unit& u) const {
        if (i >= 16) return false;
        const int e = __builtin_amdgcn_readfirstlane(aux[AUX_U2 + 4 * i]); if (e < 0) return false;
        u.e = e; u.ml = __builtin_amdgcn_readfirstlane(aux[AUX_U2 + 4 * i + 1]); u.pm = __builtin_amdgcn_readfirstlane(aux[AUX_U2 + 4 * i + 2]); u.pn = __builtin_amdgcn_readfirstlane(aux[AUX_U2 + 4 * i + 3]); return true; }
    __device__ __forceinline__ const char* a_base(const pg8::Unit& u) const { return A + (size_t)u.pm * 256 * DE * XSZ; }
    __device__ __forceinline__ const char* b_base(const pg8::Unit& u) const { return Bt + ((size_t)u.e * 1024 + u.pn * 256) * DE * XSZ; }
    __device__ __forceinline__ unsigned a_row_off(int, int) const { return 0u; }
    __device__ __forceinline__ void a_ready(const pg8::Unit& u, int wave_) const {
        if (MK_CHAIN) {
            if (wave_ == 0) { unsigned sp = 0u;
                while ((unsigned)__builtin_amdgcn_readfirstlane(__hip_atomic_load(rdy + 64 * u.pm, RLX_AGENT)) < 32u) {
                    if ((++sp & 255u) == 0u) { if (__builtin_amdgcn_readfirstlane(__hip_atomic_load(tmo, RLX_AGENT)) != 0u) break; if (sp > (1u << 18)) { if (lane_id() == 0) __hip_atomic_store(tmo, 1u, RLX_AGENT); break; } } }
#ifndef MK_CHAIN_ACQ
#define MK_CHAIN_ACQ 1
#endif
                if (MK_CHAIN_ACQ) { __builtin_amdgcn_fence(__ATOMIC_ACQUIRE, "agent");
                    asm volatile("s_waitcnt vmcnt(0)" ::: "memory"); } }
            asm volatile("" ::: "memory"); __builtin_amdgcn_s_barrier(); asm volatile("" ::: "memory");
        }
    }
};
struct EpiSwiGLU {
    static constexpr bool PERM = true;
    int wave; unsigned char* A1; unsigned* rdy;
    __device__ __forceinline__ void operator()(const f32x4 (&acc)[2][2][4][2], const pg8::Unit& u, int) const {
        int t_ = wave * 64 + lane_id(); asm volatile("" : "+v"(t_));
        const int fr = t_ & 15, fq = (t_ >> 4) & 3, wid_ = __builtin_amdgcn_readfirstlane(t_ >> 6), wr = wid_ >> 2, wc = wid_ & 3;
#pragma unroll
        for (int ai = 0; ai < 2; ++ai)
#pragma unroll
            for (int m = 0; m < 4; ++m) { const size_t slot = (size_t)u.pm * 256 + ai * 128 + wr * 64 + m * 16 + fr;
                const float ws_ = W8_INV;
                const f32x4 g0 = acc[ai][0][m][0] * ws_, g1 = acc[ai][0][m][1] * ws_, u0 = acc[ai][1][m][0] * ws_, u1 = acc[ai][1][m][1] * ws_;
                v2u w; w.x = pg8::pk4_fp8(silu_f(g0.x) * u0.x, silu_f(g0.y) * u0.y, silu_f(g0.z) * u0.z, silu_f(g0.w) * u0.w);
                w.y = pg8::pk4_fp8(silu_f(g1.x) * u1.x, silu_f(g1.y) * u1.y, silu_f(g1.z) * u1.z, silu_f(g1.w) * u1.w);
                unsigned char* dp = A1 + slot * DE + u.pn * 128 + wc * 32 + 8 * fq;
                if (MK_CHAIN) __hip_atomic_store((GAS unsigned long long*)dp, ((unsigned long long)w.y << 32) | (unsigned long long)w.x, RLX_AGENT);
                else *(GAS v2u*)dp = w; }
        if (MK_CHAIN) {
            asm volatile("s_waitcnt vmcnt(0)" ::: "memory");
            if (lane_id() == 0) (void)__hip_atomic_fetch_add(rdy + 64 * u.pm, 1u, RLX_AGENT);
        }
    }
};
struct EpiDown {
    static constexpr bool PERM = true;
    int wave; unsigned char* ws; LAS int* aux;
    __device__ __forceinline__ void operator()(const f32x4 (&acc)[2][2][4][2], const pg8::Unit& u, int) const {
        int t_ = wave * 64 + lane_id(); asm volatile("" : "+v"(t_));
        const int fr = t_ & 15, fq = (t_ >> 4) & 3, wid_ = __builtin_amdgcn_readfirstlane(t_ >> 6), wr = wid_ >> 2, wc = wid_ & 3;
        unsigned char* ws_ = ws; asm volatile("" : "+s"(ws_)); unsigned char* const Y = ws_ + WS_Y; const float* const WL = (const float*)(ws_ + WS_WL);
        const int cnt = aux[AUX_CNT + u.e];
        float wvs[8];
#pragma unroll
        for (int am = 0; am < 8; ++am) { const int idx = u.ml * 256 + (am >> 2) * 128 + wr * 64 + (am & 3) * 16 + fr; wvs[am] = idx < cnt ? WL[(size_t)u.e * CAP + idx] : 0.f; }
#pragma unroll
        for (int ai = 0; ai < 2; ++ai)
#pragma unroll
            for (int m = 0; m < 4; ++m) { const int lr = ai * 128 + wr * 64 + m * 16 + fr, idx = u.ml * 256 + lr; const size_t slot = (size_t)u.pm * 256 + lr;
                if (idx < cnt) { const float wv = wvs[ai * 4 + m];
#pragma unroll
                    for (int bj = 0; bj < 2; ++bj) { const f32x4 v0 = acc[ai][bj][m][0] * wv, v1 = acc[ai][bj][m][1] * wv;
                        *(GAS v2u*)(Y + slot * DM + u.pn * 256 + bj * 128 + wc * 32 + 8 * fq) = (v2u){pg8::pk4_fp8(v0[0], v0[1], v0[2], v0[3]), pg8::pk4_fp8(v1[0], v1[1], v1[2], v1[3])}; } } }
    }
};
#ifndef MK_DUMP
#define MK_DUMP 0
#endif
#if MK_DUMP
__device__ __forceinline__ void dump_phase(Frame& F, int which) {
    const size_t n = (size_t)M * DM; const size_t g0 = (size_t)F.vcu * NTHREADS + F.tid, gs = (size_t)F.G * NTHREADS;
    const bf16* HN = (const bf16*)(F.ws + WS_HN); const bf16* PROJ = (const bf16*)(F.ws + WS_PROJ);
    LAS int* aux = (LAS int*)(F.lds + AUX_OFF);
    if (which >= 7) moe_table(F, 0);
    for (size_t i = g0; i < n; i += gs) { const size_t row = i >> 10; const int c = (int)(i & 1023); float v = 0.f;
        if (which == 1 || which == 4) v = bf2f(HN[i]);
        else if (which == 9) v = (c < 512) ? bf2f(HN[i]) : 0.f;
        else if (which == 10) v = (c >= 512) ? bf2f(HN[i]) : 0.f;
        else if (which == 2) v = bf2f(PROJ[row * NPROJ + c]) + bf2f(PROJ[row * NPROJ + 1024 + c]) + bf2f(PROJ[row * NPROJ + 2048 + c]) + bf2f(PROJ[row * NPROJ + 3072 + (c & 511)]);
        else if (which == 3) v = ((const float*)(F.ws + WS_SEG))[i & (4 * 1024 * 1024 - 1)] + ((const float*)(F.ws + WS_CL))[i & (256 * 1024 - 1)];
        else if (which == 5) v = F.out[i];
        else if (which == 6) { const int4 rt = ((const int4*)(F.ws + WS_RT))[row]; v = (c == 0) ? (float)rt.x : (c == 1) ? (float)rt.z : (c == 2) ? ((const float*)(F.ws + WS_WL))[(size_t)rt.x * CAP + rt.y] : (c == 3) ? ((const float*)(F.ws + WS_WL))[(size_t)rt.z * CAP + rt.w] : (float)(F.ws + WS_HN)[row * (size_t)DM * XSZ + c]; }
        else if (which == 7) { const int4 rt = ((const int4*)(F.ws + WS_RT))[row]; const size_t s0 = (size_t)(256 * aux[AUX_TS + rt.x] + rt.y), s1 = (size_t)(256 * aux[AUX_TS + rt.z] + rt.w);
            v = (c < 512) ? (float)(F.ws + WS_A1)[(s0 * DE + c) * XSZ] : (float)(F.ws + WS_A1)[(s1 * DE + (c - 512)) * XSZ]; }
        else if (which == 8) { const int4 rt = ((const int4*)(F.ws + WS_RT))[row]; const size_t s0 = (size_t)(256 * aux[AUX_TS + rt.x] + rt.y), s1 = (size_t)(256 * aux[AUX_TS + rt.z] + rt.w);
            v = (float)(F.ws + WS_Y)[s0 * DM + c] + (float)(F.ws + WS_Y)[s1 * DM + c]; }
        if (which != 5) F.out[i] = v; }
}
#endif
__device__ __forceinline__ void moe_fill_tok(Frame& F, const ExpertOrder1& S) {
    LAS int* aux = (LAS int*)(F.lds + AUX_OFF); const int* TOK = (const int*)(F.ws + WS_TOK);
    if (F.tid < 256) {
        int ev[6], tv[6];
#pragma unroll
        for (int k = 0; k < 6; ++k) { ev[k] = aux[AUX_U + 2 * k]; tv[k] = 0;
            if (ev[k] >= 0) { const int cnt = aux[AUX_CNT + ev[k]]; int idx = aux[AUX_U + 2 * k + 1] * 256 + F.tid; idx = idx < cnt ? idx : cnt - 1; tv[k] = TOK[(size_t)ev[k] * CAP + idx]; } }
#pragma unroll
        for (int k = 0; k < 6; ++k) if (ev[k] >= 0) aux[AUX_TOK + k * 256 + F.tid] = tv[k];
    }
    pg8::Unit u;
    for (int ui = 6; ui < AUX_MAXU && S.next(ui, u); ++ui)
        if (F.tid < 256) { const int cnt = aux[AUX_CNT + u.e]; int idx = u.ml * 256 + F.tid; idx = idx < cnt ? idx : cnt - 1;
            aux[AUX_TOK + ui * 256 + F.tid] = TOK[(size_t)u.e * CAP + idx]; }
    __syncthreads();
}
typedef __attribute__((address_space(4))) const struct Args* KArgsP;
__device__ __forceinline__ const float* kin_ptr(KArgsP ka, int i);
constexpr int PH_PER_LAYER = 8, N_PHASES = 1 + DEPTH * PH_PER_LAYER + 1;
struct Args { const float* in[14]; float* out; unsigned char* ws; int ph_lo, ph_hi; };
__device__ __forceinline__ int bx_opaque() { int c_ = (int)blockIdx.x; asm volatile("" : "+s"(c_)); return c_; }
__device__ __forceinline__ const float* kin_ptr(KArgsP ka, int i) { KArgsP k_ = ka; asm volatile("" : "+s"(k_)); return k_->in[i]; }
__global__ void __launch_bounds__(NTHREADS, 2) trunk_fwd(Args args) {
    extern __shared__ __attribute__((aligned(16))) unsigned char lds[];
    Frame F;
    F.lds = (LAS unsigned char*)lds;
    F.MISC = (volatile LAS unsigned*)(F.lds + MISC_OFF);
    F.tid = threadIdx.x; F.lane = F.tid & 63; F.wave = __builtin_amdgcn_readfirstlane(F.tid >> 6);
    F.G = gridDim.x; { const int bx = blockIdx.x; F.vcu = (F.G % 8 == 0) ? (bx % 8) * (F.G / 8) + bx / 8 : bx; }
    F.ws = args.ws; F.out = args.out; F.ctl = (gu32*)(args.ws + WS_CTL);
    for (int u = F.tid; u < 128; u += NTHREADS) ((LAS unsigned*)(F.lds + MISC_OFF))[u] = 0u;
    __syncthreads();
    if (F.lane == 0) F.MISC[64 + (__builtin_amdgcn_s_getreg(0x2804) & 63)] = (unsigned)F.wave;
    __syncthreads();
    XcdBarrier bar; bar.w0 = 0; bar.bar = (unsigned*)(F.ctl + CW_BAR); bar.x = 0; bar.st = nullptr;
    if (!MK_MULTI) bar = xcd_barrier_post((unsigned*)(F.ctl + CW_BAR), F.MISC + 8, F.wave == 0 ? 1u : 0u);
    typedef __attribute__((address_space(4))) const Args* KArgs;
    const KArgs ka = (KArgs)__builtin_amdgcn_kernarg_segment_ptr();
#define KIN(i) (kin_ptr(ka, i))
    const int lo = args.ph_lo, hi = args.ph_hi;
#ifndef MK_PHMASK
#define MK_PHMASK 0x3ff
#endif
#define IN(k) (lo <= (k) && (k) < hi)
#define EN(j) ((MK_PHMASK >> (j)) & 1)
#ifndef MK_REPMASK
#define MK_REPMASK 0
#endif
#define REP(j) for (int rep_ = 0; rep_ < 1 + ((MK_REPMASK >> (j)) & 1); ++rep_)
#define SEAM(k) do { if (IN(k) && IN((k) + 1)) xcd_barrier(bar); } while (0)
#define SEAMW(k, cl) do { if (IN(k) && IN((k) + 1)) { if (MK_BARWORK && (cl) < DEPTH) { if (xcd_barrier_arrive(bar, true)) { bool more_ = true; \
        for (;;) { if (more_) more_ = cvt_pull_chunk(F, (cl), (LAS int*)(F.lds + MISC_OFF + 14 * 4), KIN(I_WEG), KIN(I_WEU), KIN(I_WED)); if (!more_ || xcd_barrier_released(bar)) break; } \
        xcd_barrier_finish(bar); } } else xcd_barrier(bar); } } while (0)
#ifndef MK_WAVESRC
#define MK_WAVESRC 1
#endif
#define WAVE_NOW() (MK_WAVESRC == 0 ? __builtin_amdgcn_readfirstlane((int)threadIdx.x >> 6) : __builtin_amdgcn_readfirstlane((int)F.MISC[64 + (__builtin_amdgcn_s_getreg(0x2804) & 63)]))
#define REFRESH() do { F.wave = WAVE_NOW(); int t_ = F.wave * 64 + lane_id(); asm volatile("" : "+v"(t_)); F.tid = t_; F.lane = t_ & 63; \
        unsigned char* w_ = args.ws; float* o_ = args.out; asm volatile("" : "+s"(w_), "+s"(o_)); F.ws = w_; F.out = o_; F.ctl = (gu32*)(w_ + WS_CTL); \
        int g_ = F.G, v_ = F.vcu; asm volatile("" : "+s"(g_), "+s"(v_)); F.G = g_; F.vcu = v_; } while (0)

    if (EN(0) && IN(0)) REP(0) { REFRESH(); p0_prologue(F, KIN(I_WIN), KIN(I_WOUT), KIN(I_WEG), KIN(I_WEU), KIN(I_WED), KIN(I_WRG), KIN(I_WRE)); }

    for (int layer = 0; layer < DEPTH; ++layer) {
        const int pb = 1 + layer * PH_PER_LAYER;
        const float* xin = KIN(I_X);
        if (EN(1) && IN(pb + 0)) { REFRESH();
            if (layer == 0) REP(1) pa_phase<false, false>(F, xin, F.out, KIN(I_NMIX), 0, KIN(I_WIN), KIN(I_FB), 0);
            else pa_phase<true, false>(F, xin, F.out, KIN(I_NMIX) + layer * DM, layer, nullptr, KIN(I_FB) + layer * FH, layer - 1);
        }
        SEAMW(pb + 0, layer);
#if MK_DUMP
        if (layer == 0 && MK_DUMP == 1) { REFRESH(); dump_phase(F, 1); return; }
#endif
        if (EN(2) && IN(pb + 1)) { REFRESH();
            pg8::DenseOrder<M / 256, NPROJ / 256> S; S.init(F.ws + WS_HN, (const bf16*)(F.ws + WS_WIN) + (size_t)layer * NPROJ * DM, DM, F.G, bx_opaque());
            EpiProj E{F.wave, (bf16*)(F.ws + WS_PROJ), (const float*)(F.ws + WS_ROT), (unsigned*)(F.ctl + CW_KB + layer * 512)};
#ifdef MK_EPIPROBE
            pg8::gemm_phase<EpiProj, pg8::DenseOrder<M / 256, NPROJ / 256>, true>(F.lds, DM, S, E, F.wave);
            { EpiProjT<true> E2{F.wave, (bf16*)(F.ws + WS_PROJ), (const float*)(F.ws + WS_ROT), (unsigned*)(F.ctl + CW_KB + layer * 512)}; __syncthreads(); pg8::gemm_phase<EpiProjT<true>, pg8::DenseOrder<M / 256, NPROJ / 256>, true>(F.lds, DM, S, E2, F.wave); }
#else
            REP(2) pg8::gemm_phase<EpiProj, pg8::DenseOrder<M / 256, NPROJ / 256>, true>(F.lds, DM, S, E, F.wave);
#endif
        }
        SEAMW(pb + 1, layer);
#if MK_DUMP
        if (layer == 0 && MK_DUMP == 2) { REFRESH(); dump_phase(F, 2); return; }
#endif
        if (EN(3) && IN(pb + 2)) REP(3) { REFRESH(); ret_passA(F); cl_tables(F); }
        SEAMW(pb + 2, layer);
#if MK_DUMP
        if (layer == 0 && MK_DUMP == 3) { REFRESH(); dump_phase(F, 3); return; }
#endif
        if (EN(4) && IN(pb + 3)) { REFRESH();
            REP(4) pc_phase(F, layer, layer + 2 * rep_, KIN(I_WIN), KIN(I_WOUT), KIN(I_WEG), KIN(I_WEU), KIN(I_WED));
        }
        SEAMW(pb + 3, layer + 1);
#if MK_DUMP
        if (layer == 0 && (MK_DUMP == 4 || MK_DUMP == 9 || MK_DUMP == 10)) { REFRESH(); dump_phase(F, MK_DUMP); return; }
#endif
        if (EN(5) && IN(pb + 4)) { REFRESH();
            pg8::DenseOrder<M / 256, DM / 256, MSZ> S; S.init(F.ws + WS_HN, F.ws + WS_WOUT + (size_t)layer * DM * DM * MSZ, DM, F.G, bx_opaque());
            EpiRes E{F.wave, layer == 0 ? xin : nullptr, (bf16*)(F.ws + WS_XB), (float*)(F.ws + WS_ROWSS)};
            for (int rep_ = 0; rep_ < 1 + (layer == 0 ? ((MK_REPMASK >> 5) & 1) : 0); ++rep_) pg8::gemm_phase<EpiRes, pg8::DenseOrder<M / 256, DM / 256, MSZ>, true, MSZ>(F.lds, DM, S, E, F.wave);
        }
        SEAMW(pb + 4, layer + 1);
#if MK_DUMP
        if (layer == 0 && MK_DUMP == 5) { REFRESH(); dump_phase(F, 5); return; }
#endif
        if (EN(6) && IN(pb + 5)) { REFRESH(); pf_phase(F, layer, KIN(I_BRG) + layer * NG, KIN(I_BRE) + layer * NE, KIN(I_NFFN) + layer * DM); }
        SEAMW(pb + 5, layer + 1);
#if MK_DUMP
        if (layer == 0 && MK_DUMP == 6) { REFRESH(); dump_phase(F, 6); return; }
#endif
        if (EN(7) && IN(pb + 6)) { REFRESH();
            moe_table(F, layer);
            ExpertOrder1 S{(const char*)(F.ws + WS_HN), (const char*)(F.ws + WS_W1) + (size_t)layer * NE * 1024 * 1024 * XSZ, (LAS int*)(F.lds + AUX_OFF), F.G, F.vcu};
            moe_fill_tok(F, S);
            EpiSwiGLU E{F.wave, F.ws + WS_A1, (unsigned*)(F.ctl + CW_RDY + layer * MAXTILES * 64)};
            REP(7) pg8::gemm_phase<EpiSwiGLU, ExpertOrder1, true, XSZ>(F.lds, DM, S, E, F.wave);
        }
        if (!MK_CHAIN) SEAM(pb + 6);
#if MK_DUMP
        if (layer == 0 && MK_DUMP == 7) { REFRESH(); dump_phase(F, 7); return; }
#endif
        if (EN(8) && IN(pb + 7)) { REFRESH();
            if (MK_MULTI) moe_table(F, layer);
            ExpertOrder2 S{(const char*)(F.ws + WS_A1), (const char*)(F.ws + WS_W2) + (size_t)layer * NE * 1024 * DE * XSZ, (LAS int*)(F.lds + AUX_OFF), F.G, F.vcu, (const unsigned*)(F.ctl + CW_RDY + layer * MAXTILES * 64), (unsigned*)(F.ctl + CW_BAR + XB_TMO)};
            EpiDown E{F.wave, F.ws, (LAS int*)(F.lds + AUX_OFF)};
            REP(8) pg8::gemm_phase<EpiDown, ExpertOrder2, true, XSZ>(F.lds, DE, S, E, F.wave);
        }
        SEAM(pb + 7);
#if MK_DUMP
        if (layer == 0 && MK_DUMP == 8) { REFRESH(); dump_phase(F, 8); return; }
#endif
    }
    if (EN(9) && IN(N_PHASES - 1)) REP(9) { REFRESH(); pa_phase<true, true>(F, F.out, F.out, KIN(I_NFIN), 0, nullptr, nullptr, DEPTH - 1); }
#undef IN
#undef SEAM
}

extern "C" void kernel_launch(void* const* d_in, const int* in_sizes, int n_in, void* d_out, int out_size, void* d_ws, size_t ws_size, hipStream_t stream) {
    static int grid = 0;
    if (grid == 0) {
        if (n_in != 14 || in_sizes[0] != M * DM || out_size != M * DM || ws_size < WS_END) {
            fprintf(stderr, "kernel_launch: unexpected problem (n_in %d, in0 %d, out %d, ws %zu < %zu?); nothing launched\n", n_in, n_in > 0 ? in_sizes[0] : -1, out_size, ws_size, (size_t)WS_END); grid = -1; return; }
        int dev = 0, cus = 0;
        if (hipGetDevice(&dev) != hipSuccess || hipDeviceGetAttribute(&cus, hipDeviceAttributeMultiprocessorCount, dev) != hipSuccess) { grid = -1; return; }
        if (hipFuncSetAttribute((const void*)trunk_fwd, hipFuncAttributeMaxDynamicSharedMemorySize, LDS_BYTES) != hipSuccess) { fprintf(stderr, "kernel_launch: hipFuncSetAttribute failed\n"); grid = -1; return; }
        int per_cu = 0;
        if (hipOccupancyMaxActiveBlocksPerMultiprocessor(&per_cu, (const void*)trunk_fwd, NTHREADS, LDS_BYTES) != hipSuccess || per_cu < 1)
            fprintf(stderr, "kernel_launch: note: occupancy query reports %d workgroups per CU\n", per_cu);
        (void)hipGetLastError();
        grid = cus;
    }
    if (grid < 0) return;
    if (hipMemsetAsync((char*)d_ws + WS_CTL, 0, CTL_ZERO_BYTES, stream) != hipSuccess) return;
    Args a{};
    for (int i = 0; i < 14; ++i) a.in[i] = (const float*)d_in[i];
    a.out = (float*)d_out; a.ws = (unsigned char*)d_ws;
#if MK_MULTI
    for (int p = 0; p < N_PHASES; ++p) { a.ph_lo = p; a.ph_hi = p + 1; hipLaunchKernelGGL(trunk_fwd, dim3(grid), dim3(NTHREADS), LDS_BYTES, stream, a); }
#else
    a.ph_lo = 0; a.ph_hi = N_PHASES;
    hipLaunchKernelGGL(trunk_fwd, dim3(grid), dim3(NTHREADS), LDS_BYTES, stream, a);
#endif
}
```
